# Optimizing an MI355X kernel written in HIP

```python
import jax, jax.numpy as jnp
from jax import lax
import numpy as np

D_MODEL = 1024
BATCH = 16
SEQ = 2048
DEPTH = 2

MEM_LEN = 256
Q_BLOCK = 128
ROPE_THETA = 10000.0
NORM_EPS = 1e-6
FOX_HEADS = 6
FOX_DIM = 64
FORGET_BIAS_MEAN = 2.0
MLA_HEADS = 6
MLA_NOPE = 64
MLA_ROPE = 32
MLA_V = 64
MLA_Q_RANK = 256
MLA_KV_RANK = 128
DSA_HEADS = 4
DSA_DIM = 64
IDX_HEADS = 8
IDX_DIM = 32
TOPK_MAX = 256
XA_HEADS = 4
XA_DIM = 128
D_FF = 2816
IN_SIZES = (FOX_HEADS * FOX_DIM, FOX_HEADS * FOX_DIM, FOX_HEADS * FOX_DIM, FOX_HEADS,
            MLA_Q_RANK, MLA_KV_RANK, MLA_ROPE,
            DSA_HEADS * DSA_DIM, DSA_DIM, DSA_DIM, IDX_HEADS * IDX_DIM, IDX_DIM, IDX_HEADS)
D_IN = sum(IN_SIZES)
D_MIX = FOX_HEADS * FOX_DIM + MLA_HEADS * MLA_V + DSA_HEADS * DSA_DIM

kernel_name = "hybrid_fox_mla_dsa_macaron_block"


def _rmsnorm(x, g):
    xf = x.astype(jnp.float32)
    y = xf * lax.rsqrt(jnp.mean(xf * xf, axis=-1, keepdims=True) + NORM_EPS)
    return (y * g.astype(jnp.float32)).astype(x.dtype)


def _rope(x, pos):
    half = x.shape[-1] // 2
    inv = ROPE_THETA ** (-jnp.arange(half, dtype=jnp.float32) / half)
    ang = pos.astype(jnp.float32)[:, None] * inv[None, :]
    cos = jnp.cos(ang)[:, None, :]
    sin = jnp.sin(ang)[:, None, :]
    xf = x.astype(jnp.float32)
    x1, x2 = xf[..., :half], xf[..., half:]
    return jnp.concatenate([x1 * cos - x2 * sin, x2 * cos + x1 * sin], axis=-1).astype(x.dtype)


def _swiglu(h, wi, wo):
    gate, up = jnp.split(h @ wi, 2, axis=-1)
    return (jax.nn.silu(gate) * up) @ wo


def _split(a, sizes):
    offsets = [int(o) for o in np.cumsum(sizes)[:-1]]
    return jnp.split(a, offsets, axis=-1)


def _to_blocks(a):
    b, s = a.shape[0], a.shape[1]
    a = a.reshape((b, s // Q_BLOCK, Q_BLOCK) + a.shape[2:])
    return jnp.moveaxis(a, 1, 0)


def _from_blocks(a):
    a = jnp.moveaxis(a, 0, 1)
    return a.reshape((a.shape[0], a.shape[1] * a.shape[2]) + a.shape[3:])


def _causal_block_attention(q, k, v, cum_logf=None):
    s_len = q.shape[1]
    nb = s_len // Q_BLOCK
    scale = q.shape[-1] ** -0.5
    pos = jnp.arange(s_len)
    fk = None if cum_logf is None else jnp.swapaxes(cum_logf, 1, 2)

    def one_block(args):
        qb, pb, fb = args
        s = jnp.einsum('bqhd,bkhd->bhqk', qb, k).astype(jnp.float32) * scale
        if fk is not None:
            s = s + (jnp.swapaxes(fb, 1, 2)[..., :, None] - fk[:, :, None, :])
        s = jnp.where((pb[:, None] >= pos[None, :])[None, None], s, -jnp.inf)
        p = jax.nn.softmax(s, axis=-1).astype(v.dtype)
        return jnp.einsum('bhqk,bkhd->bqhd', p, v)

    fq = None if cum_logf is None else _to_blocks(cum_logf)
    out = lax.map(one_block, (_to_blocks(q), pos.reshape(nb, Q_BLOCK), fq))
    return _from_blocks(out)


def _dsa_attention(q, k, v, qi, ki, wi, n_sel):
    s_len = q.shape[1]
    nb = s_len // Q_BLOCK
    scale = q.shape[-1] ** -0.5
    pos = jnp.arange(s_len)
    gather = jax.vmap(lambda t, i: t[i])

    def one_block(args):
        qb, qib, wb, pb = args
        sc = jnp.einsum('bqhd,bkd->bqhk', qib, ki).astype(jnp.float32) * (IDX_DIM ** -0.5)
        iscore = jnp.einsum('bqhk,bqh->bqk', jax.nn.relu(sc), wb.astype(jnp.float32))
        iscore = jnp.where((pb[:, None] >= pos[None, :])[None], iscore, -jnp.inf)
        _, sel = lax.top_k(iscore, n_sel)
        valid = sel <= pb[None, :, None]
        k_sel = gather(k, sel)
        v_sel = gather(v, sel)
        s = jnp.einsum('bqhd,bqkd->bqhk', qb, k_sel).astype(jnp.float32) * scale
        s = jnp.where(valid[:, :, None, :], s, -jnp.inf)
        p = jax.nn.softmax(s, axis=-1).astype(v.dtype)
        return jnp.einsum('bqhk,bqkd->bqhd', p, v_sel)

    out = lax.map(one_block, (_to_blocks(q), _to_blocks(qi), _to_blocks(wi),
                              pos.reshape(nb, Q_BLOCK)))
    return _from_blocks(out)


def setup_inputs(seed: int = 0) -> dict:
    key = jax.random.key(seed)
    ks = iter(jax.random.split(key, 32))
    f32 = jnp.float32

    def w(shape, fan_in):
        return jax.random.normal(next(ks), shape, f32) * (fan_in ** -0.5)

    def gain(shape):
        return 1.0 + 0.05 * jax.random.normal(next(ks), shape, f32)

    L = DEPTH
    return {
        'x': jax.random.normal(next(ks), (BATCH, SEQ, D_MODEL), f32),
        'mem': jax.random.normal(next(ks), (BATCH, MEM_LEN, D_MODEL), f32),
        'ffn1_norm': gain((L, D_MODEL)),
        'ffn1_wi': w((L, D_MODEL, 2 * D_FF), D_MODEL),
        'ffn1_wo': w((L, D_FF, D_MODEL), D_FF),
        'mix_norm': gain((L, D_MODEL)),
        'w_in': w((L, D_MODEL, D_IN), D_MODEL),
        'b_forget': FORGET_BIAS_MEAN + 0.1 * jax.random.normal(next(ks), (L, FOX_HEADS), f32),
        'mla_q_norm': gain((L, MLA_Q_RANK)),
        'mla_w_uq': w((L, MLA_Q_RANK, MLA_HEADS * (MLA_NOPE + MLA_ROPE)), MLA_Q_RANK),
        'mla_kv_norm': gain((L, MLA_KV_RANK)),
        'mla_w_ukv': w((L, MLA_KV_RANK, MLA_HEADS * (MLA_NOPE + MLA_V)), MLA_KV_RANK),
        'w_out': w((L, D_MIX, D_MODEL), D_MIX),
        'xa_norm': gain((L, D_MODEL)),
        'mem_norm': gain((L, D_MODEL)),
        'xa_wq': w((L, D_MODEL, XA_HEADS * XA_DIM), D_MODEL),
        'xa_wkv': w((L, D_MODEL, 2 * XA_HEADS * XA_DIM), D_MODEL),
        'xa_wo': w((L, XA_HEADS * XA_DIM, D_MODEL), XA_HEADS * XA_DIM),
        'ffn2_norm': gain((L, D_MODEL)),
        'ffn2_wi': w((L, D_MODEL, 2 * D_FF), D_MODEL),
        'ffn2_wo': w((L, D_FF, D_MODEL), D_FF),
        'final_norm': gain((D_MODEL,)),
    }


def reference(x, mem, ffn1_norm, ffn1_wi, ffn1_wo, mix_norm, w_in, b_forget,
              mla_q_norm, mla_w_uq, mla_kv_norm, mla_w_ukv, w_out,
              xa_norm, mem_norm, xa_wq, xa_wkv, xa_wo,
              ffn2_norm, ffn2_wi, ffn2_wo, final_norm):
    b, s_len, _ = x.shape
    m_len = mem.shape[1]
    pos = jnp.arange(s_len)
    n_sel = min(TOPK_MAX, s_len // 4)

    for l in range(DEPTH):
        x = x + 0.5 * _swiglu(_rmsnorm(x, ffn1_norm[l]), ffn1_wi[l], ffn1_wo[l])

        h = _rmsnorm(x, mix_norm[l])
        (fq, fk, fv, ff, mcq, mckv, mkr,
         dq, dk, dv, dqi, dki, dwi) = _split(h @ w_in[l], IN_SIZES)

        log_f = jax.nn.log_sigmoid((ff + b_forget[l]).astype(jnp.float32))
        cum_logf = jnp.cumsum(log_f, axis=1)
        a_out = _causal_block_attention(
            fq.reshape(b, s_len, FOX_HEADS, FOX_DIM),
            fk.reshape(b, s_len, FOX_HEADS, FOX_DIM),
            fv.reshape(b, s_len, FOX_HEADS, FOX_DIM), cum_logf)

        qm = (_rmsnorm(mcq, mla_q_norm[l]) @ mla_w_uq[l]).reshape(
            b, s_len, MLA_HEADS, MLA_NOPE + MLA_ROPE)
        q_nope, q_rope = qm[..., :MLA_NOPE], qm[..., MLA_NOPE:]
        kvm = (_rmsnorm(mckv, mla_kv_norm[l]) @ mla_w_ukv[l]).reshape(
            b, s_len, MLA_HEADS, MLA_NOPE + MLA_V)
        k_nope, v_m = kvm[..., :MLA_NOPE], kvm[..., MLA_NOPE:]
        k_rope = _rope(mkr.reshape(b, s_len, 1, MLA_ROPE), pos)
        q_m = jnp.concatenate([q_nope, _rope(q_rope, pos)], axis=-1)
        k_m = jnp.concatenate(
            [k_nope, jnp.broadcast_to(k_rope, (b, s_len, MLA_HEADS, MLA_ROPE))], axis=-1)
        b_out = _causal_block_attention(q_m, k_m, v_m)

        q_c = _rope(dq.reshape(b, s_len, DSA_HEADS, DSA_DIM), pos)
        k_c = _rope(dk.reshape(b, s_len, 1, DSA_DIM), pos)[:, :, 0]
        qi = _rope(dqi.reshape(b, s_len, IDX_HEADS, IDX_DIM), pos)
        ki = _rope(dki.reshape(b, s_len, 1, IDX_DIM), pos)[:, :, 0]
        wi = dwi * (IDX_HEADS ** -0.5)
        c_out = _dsa_attention(q_c, k_c, dv, qi, ki, wi, n_sel)

        mixed = jnp.concatenate([a_out.reshape(b, s_len, -1), b_out.reshape(b, s_len, -1),
                                 c_out.reshape(b, s_len, -1)], axis=-1)
        x = x + mixed @ w_out[l]

        hq = _rmsnorm(x, xa_norm[l])
        hm = _rmsnorm(mem, mem_norm[l])
        qx = (hq @ xa_wq[l]).reshape(b, s_len, XA_HEADS, XA_DIM)
        kx, vx = jnp.split((hm @ xa_wkv[l]).reshape(b, m_len, 2 * XA_HEADS, XA_DIM), 2, axis=2)
        sx = jnp.einsum('bqhd,bmhd->bhqm', qx, kx).astype(jnp.float32) * (XA_DIM ** -0.5)
        px = jax.nn.softmax(sx, axis=-1).astype(vx.dtype)
        ox = jnp.einsum('bhqm,bmhd->bqhd', px, vx).reshape(b, s_len, XA_HEADS * XA_DIM)
        x = x + ox @ xa_wo[l]

        x = x + 0.5 * _swiglu(_rmsnorm(x, ffn2_norm[l]), ffn2_wi[l], ffn2_wo[l])

    return _rmsnorm(x, final_norm)
```

```cpp
#include <hip/hip_runtime.h>
#include <cstdio>
#include <cstdint>
#include <math.h>

#define GAS __attribute__((address_space(1)))
#define LAS __attribute__((address_space(3)))
typedef _Float16 half_t;
typedef _Float16 h8 __attribute__((ext_vector_type(8)));
typedef _Float16 h4 __attribute__((ext_vector_type(4)));
typedef _Float16 h2 __attribute__((ext_vector_type(2)));
typedef short s16x8 __attribute__((ext_vector_type(8)));
typedef short s16x4 __attribute__((ext_vector_type(4)));
typedef float f32x2 __attribute__((ext_vector_type(2)));
typedef float f32x4 __attribute__((ext_vector_type(4)));
typedef float f32x16 __attribute__((ext_vector_type(16)));
typedef unsigned u32x2 __attribute__((ext_vector_type(2)));
typedef unsigned u32x4 __attribute__((ext_vector_type(4)));
typedef GAS unsigned gu32;

constexpr int D = 1024, S = 2048, NB = 16, M = NB * S, DFF = 2816, DIN = 2254, MEM = 256, MM = NB * MEM;
constexpr int NWIN = 2304;
constexpr int C_FQ = 0, C_FK = 384, C_FV = 768, C_FF = 1152, C_MCQ = 1158, C_MCKV = 1414, C_MKR = 1542,
              C_DQ = 1574, C_DK = 1830, C_DV = 1894, C_DQI = 1958, C_DKI = 2214, C_DWI = 2246;
constexpr float EPS = 1e-6f, LOG2E = 1.4426950408889634f;

constexpr size_t MiB = 1u << 20;
constexpr size_t WS_CTL = 0, CTL_ZERO_BYTES = 1 * MiB;
constexpr size_t WL_WI1 = 0;
constexpr size_t WL_WO1 = WL_WI1 + (size_t)5632 * 1024 * 2;
constexpr size_t WL_WIN = WL_WO1 + (size_t)1024 * 2816 * 2;
constexpr size_t WL_WUQ = WL_WIN + (size_t)NWIN * 1024 * 2;
constexpr size_t WL_WUKV = WL_WUQ + (size_t)768 * 256 * 2;
constexpr size_t WL_WOUT = WL_WUKV + (size_t)768 * 128 * 2;
constexpr size_t WL_XWQ = WL_WOUT + (size_t)1024 * 1024 * 2;
constexpr size_t WL_XWKV = WL_XWQ + (size_t)512 * 1024 * 2;
constexpr size_t WL_XWO = WL_XWKV + (size_t)1024 * 1024 * 2;
constexpr size_t WL_WI2 = WL_XWO + (size_t)1024 * 512 * 2;
constexpr size_t WL_WO2 = WL_WI2 + (size_t)5632 * 1024 * 2;
constexpr size_t WL_BYTES = WL_WO2 + (size_t)1024 * 2816 * 2;
constexpr size_t WL_STRIDE = (WL_BYTES + 4095) & ~(size_t)4095;
constexpr size_t WS_W = 1 * MiB;
constexpr size_t WS_TAB = WS_W + 2 * WL_STRIDE;
constexpr size_t TAB_BYTES = (size_t)2048 * (16 + 16 + 32 + 32) * 4;
constexpr size_t WS_XN = (WS_TAB + TAB_BYTES + 4095) & ~(size_t)4095;
constexpr size_t WS_SS = WS_XN + (size_t)M * D * 2;
constexpr size_t WS_MEMB = WS_SS + (size_t)M * 16 * 4;
constexpr size_t WS_MEMSS = WS_MEMB + (size_t)MM * D * 2;
constexpr size_t WS_MEMKV = WS_MEMSS + (size_t)MM * 4;
constexpr size_t WS_BIG = (WS_MEMKV + (size_t)MM * D * 2 + 4095) & ~(size_t)4095;
constexpr size_t WS_HID = WS_BIG;
constexpr size_t WS_QF = WS_BIG;
constexpr size_t WS_KF = WS_QF + (size_t)M * 384 * 2;
constexpr size_t WS_VF = WS_KF + (size_t)M * 384 * 2;
constexpr size_t WS_MCQ = WS_VF + (size_t)M * 384 * 2;
constexpr size_t WS_MCKV = WS_MCQ + (size_t)M * 256 * 2;
constexpr size_t WS_DQ = WS_MCKV + (size_t)M * 128 * 2;
constexpr size_t WS_DK = WS_DQ + (size_t)M * 256 * 2;
constexpr size_t WS_DV = WS_DK + (size_t)M * 64 * 2;
constexpr size_t WS_DQI = WS_DV + (size_t)M * 64 * 2;
constexpr size_t WS_DKI = WS_DQI + (size_t)M * 256 * 2;
constexpr size_t WS_KR = WS_DKI + (size_t)M * 32 * 2;
constexpr size_t WS_SMALL = WS_KR + (size_t)M * 32 * 2;
constexpr size_t WS_CUM = WS_SMALL + (size_t)M * 16 * 4;
constexpr size_t WS_SSQ = WS_CUM + (size_t)NB * 6 * S * 4;
constexpr size_t WS_SSKV = WS_SSQ + (size_t)M * 4 * 4;
constexpr size_t WS_QUP = WS_SSKV + (size_t)M * 4 * 4;
constexpr size_t WS_KVUP = WS_QUP + (size_t)M * 576 * 2;
constexpr size_t WS_MASK = WS_KVUP + (size_t)M * 768 * 2;
constexpr size_t WS_MIX = WS_MASK + (size_t)M * 64 * 4;
constexpr size_t WS_QX = WS_QF;
constexpr size_t WS_OX = WS_QX + (size_t)M * 512 * 2;
constexpr size_t WS_END = WS_MIX + (size_t)M * D * 2;
static_assert(WS_OX + (size_t)M * 512 * 2 <= WS_MCQ, "QX/OX overlay QF/KF/VF");
static_assert(WS_HID + (size_t)M * DFF * 2 <= WS_END, "HID inside BIG");
constexpr size_t WS_CUM2 = WS_END;
constexpr size_t WS_KN = WS_CUM2 + (size_t)NB * 6 * S * 4;
constexpr size_t WS_END2 = WS_KN + (size_t)NB * 6 * 32 * 4;
static_assert(WS_END2 + (2u << 20) <= 512 * MiB, "workspace budget");

constexpr int CW_BAR = 4096;
constexpr int CW_QUEUE = 8192;

constexpr int RING_BYTES = 131072;
constexpr int MISC_OFF = RING_BYTES;
constexpr int LDS_BYTES = 147456;
constexpr int NWAVES = 8, NTHREADS = 512;

#define LDS_WAIT() asm volatile("s_waitcnt lgkmcnt(0)" ::: "memory")
#define VM_WAIT() asm volatile("s_waitcnt vmcnt(0)" ::: "memory")
#define RLX_AGENT __ATOMIC_RELAXED, __HIP_MEMORY_SCOPE_AGENT

__device__ __forceinline__ unsigned pkh(float lo, float hi) { f32x2 v = {lo, hi}; h2 h = __builtin_convertvector(v, h2); return __builtin_bit_cast(unsigned, h); }
__device__ __forceinline__ float wave_sum(float v) {
#pragma unroll
    for (int o = 1; o < 64; o <<= 1) v += __shfl_xor(v, o);
    return v;
}
__device__ __forceinline__ float zf() { float z = 0.f; asm volatile("" : "+v"(z)); return z; }
__device__ __forceinline__ unsigned ou(unsigned x) { asm volatile("" : "+v"(x)); return x; }
__device__ __forceinline__ float bperm_f(int srclane, float v) { return __int_as_float(__builtin_amdgcn_ds_bpermute(srclane << 2, __float_as_int(v))); }
__device__ __forceinline__ unsigned bperm_u(int srclane, unsigned v) { return (unsigned)__builtin_amdgcn_ds_bpermute(srclane << 2, (int)v); }
__host__ __device__ __forceinline__ int perm32(int rho) { const int n = rho >> 4, i = rho & 15; return 8 * (i >> 2) + 4 * n + (i & 3); }

#define XB_TMO      128
#define XB_XCNT(j)  (256  + 64 * (j))
#define XB_XSUB(j)  (1280 + 64 * (j))
#define XB_XGEN(j)  (2304 + 64 * (j))
#define XB_TOP      3328
#define XB_TOPGEN   3392
#define XCD_BAR_WORDS 3456
#define XB_SPIN_CAP (1u << 18)

__device__ __forceinline__ unsigned xb_ld(unsigned* p)              { return __hip_atomic_load(p, __ATOMIC_RELAXED, __HIP_MEMORY_SCOPE_AGENT); }
__device__ __forceinline__ unsigned xb_add(unsigned* p, unsigned v) { return __hip_atomic_fetch_add(p, v, __ATOMIC_RELAXED, __HIP_MEMORY_SCOPE_AGENT); }
__device__ __forceinline__ unsigned xb_xcc_id() { return (unsigned)__builtin_amdgcn_s_getreg((3 << 11) | 20) & 0xFu; }
#define XB_SPIN(cond, bar) do { unsigned _sp = 0; while (cond) { __builtin_amdgcn_s_sleep(1); \
    if ((++_sp & 255u) == 0u) { if (xb_ld(&(bar)[XB_TMO])) break; if (_sp > XB_SPIN_CAP) { atomicAdd(&(bar)[XB_TMO], 1u); break; } } } } while (0)

struct XcdBarrier {
    unsigned* bar; unsigned x;
    volatile LAS unsigned* st;
};

__device__ __forceinline__ XcdBarrier xcd_barrier_post(unsigned* bar, volatile LAS unsigned* st) {
    XcdBarrier b; b.bar = bar; b.x = xb_xcc_id(); b.st = st;
    if (threadIdx.x == 0) (void)xb_add(&bar[XB_XCNT(b.x)], 1u);
    return b;
}
__device__ __forceinline__ void xcd_barrier_complete(unsigned* bar, unsigned x, unsigned& nloc, unsigned& nx) {
    const unsigned G = gridDim.x * gridDim.y * gridDim.z;
    unsigned sum, cnt, mine, sp = 0u;
    for (;;) {
        sum = 0u; cnt = 0u; mine = 0u;
#pragma unroll
        for (unsigned j = 0; j < 16; ++j) { const unsigned c = xb_ld(&bar[XB_XCNT(j)]); sum += c; cnt += (c > 0u) ? 1u : 0u; mine = (j == x) ? c : mine; }
        if (sum == G) break;
        __builtin_amdgcn_s_sleep(1);
        if ((++sp & 255u) == 0u) { if (xb_ld(&bar[XB_TMO])) break; if (sp > XB_SPIN_CAP) { atomicAdd(&bar[XB_TMO], 1u); break; } }
    }
    nloc = mine > 0u ? mine : 1u; nx = cnt > 0u ? cnt : 1u;
}

__device__ __forceinline__ void xcd_barrier(const XcdBarrier& b) {
    asm volatile("s_waitcnt vmcnt(0)" ::: "memory");
    __syncthreads();
    if (threadIdx.x == 0) {
        unsigned* bar = b.bar;
        __builtin_amdgcn_s_waitcnt(0);
        unsigned nloc = b.st[0], nx = b.st[1];
        if (nloc == 0u) { xcd_barrier_complete(bar, b.x, nloc, nx); b.st[0] = nloc; b.st[1] = nx; }
        const unsigned old = xb_add(&bar[XB_XSUB(b.x)], 1u);
        const unsigned gen = old / nloc;
        if (old + 1u == (gen + 1u) * nloc) {
            __builtin_amdgcn_fence(__ATOMIC_RELEASE, "agent");
            asm volatile("s_waitcnt vmcnt(0)" ::: "memory");
            const unsigned og = xb_add(&bar[XB_TOP], 1u);
            const unsigned tg = og / nx;
            if (og + 1u == (tg + 1u) * nx) xb_add(&bar[XB_TOPGEN], 1u);
            else XB_SPIN(xb_ld(&bar[XB_TOPGEN]) == tg, bar);
            __builtin_amdgcn_fence(__ATOMIC_ACQUIRE, "agent");
            xb_add(&bar[XB_XGEN(b.x)], 1u);
            asm volatile("s_waitcnt vmcnt(0)" ::: "memory");
        } else {
            XB_SPIN(xb_ld(&bar[XB_XGEN(b.x)]) == gen, bar);
            __builtin_amdgcn_fence(__ATOMIC_ACQUIRE, "agent");
            asm volatile("s_waitcnt vmcnt(0)" ::: "memory");
        }
    }
    __syncthreads();
}

namespace pg8 {
#define PG8_LAS __attribute__((address_space(3)))
constexpr int BM = 256, BK = 64, HALF = 128, HTB = HALF * BK * 2  , STAGE_BYTES = 8 * HTB, NXCD = 8, WGM = 8;

__host__ __device__ __forceinline__ int lds_byte(int r, int c) { const int st = (r >> 4) * 2 + (c >> 5), rr = r & 15, cc = c & 31, ob = rr * 64 + cc * 2; return st * 1024 + (ob ^ (((ob >> 9) & 1) << 5)); }
__host__ __device__ __forceinline__ void stage_rc(int b, int& R, int& C) { const int st = b / 1024, sb = b % 1024, swz = sb ^ (((sb >> 9) & 1) << 5); R = (st >> 1) * 16 + swz / 64; C = (st & 1) * 32 + (swz % 64) / 2; }
struct Unit { int pm, pn, ord; };
struct Gemm { const half_t* A; const half_t* Bt; int M, N, K; };

struct StaticOrder {
    int nM, nN, nwg, G, c;
    __host__ __device__ void init(int M, int N, int G_, int c_) { nM = M / BM; nN = N / BM; nwg = nM * nN; G = G_; c = c_; }
    __host__ __device__ bool next(int i, Unit& u) const {
        const long L = (long)i * G + c; if (L >= nwg) return false;
        int wgid = (int)L; { const int q = nwg / NXCD, r = nwg % NXCD, xcd = wgid % NXCD, off = wgid / NXCD; wgid = (xcd < r ? xcd * (q + 1) : r * (q + 1) + (xcd - r) * q) + off; }
        const int nig = WGM * nN, gid = wgid / nig, fm = gid * WGM, gsz = (nM - fm) < WGM ? (nM - fm) : WGM;
        u.pm = fm + ((wgid % nig) % gsz); u.pn = (wgid % nig) / gsz; u.ord = i; return true;
    }
    __device__ __forceinline__ void a_ready(const Unit&) const {}
    __device__ __forceinline__ void done(const Unit&) const {}
};

template <class Epi, class Sched, bool ALIGN_EPI = false, bool SP2 = false>
__device__ __forceinline__ void gemm_phase(PG8_LAS unsigned char* lds, const Gemm g, const Sched& S, const Epi& E, int tid_in) {
    int tid_ = tid_in; asm volatile("" : "+v"(tid_));
    const int tid = tid_, wid = __builtin_amdgcn_readfirstlane(tid >> 6), lane = tid & 63, wr = wid >> 2, wc = wid & 3, fr = lane & 15, fq = lane >> 4;
    int K_ = g.K; asm volatile("" : "+s"(K_));
    const int K = K_, nt = K / BK;
    unsigned voffA[2], voffB[2];
#pragma unroll
    for (int i = 0; i < 2; ++i) { int R, C; stage_rc(tid * 16 + i * 8192, R, C); const int Rb = Epi::PERM ? ((R & ~31) + perm32(R & 31)) : R;
        voffA[i] = (unsigned)(R * K + C) * 2u; voffB[i] = (unsigned)(Rb * K + C) * 2u; }
    const size_t kstep = (size_t)(BK * 2);
    const size_t hstep = (size_t)HALF * K * 2;
    const size_t tstep = 2 * hstep;
    const unsigned ldsw = (unsigned)wid * 1024u;
    const int aoff = lds_byte(wr * 64 + fr, fq * 8), boff = lds_byte(wc * 32 + fr, fq * 8);
#define PG8_SA(b, h) (((b) * 2 + (h)) * HTB)
#define PG8_SB(b, h) ((4 + (b) * 2 + (h)) * HTB)
#define PG8_STAGE(bufoff, gbase, voff) do { _Pragma("unroll") for (int _i = 0; _i < 2; ++_i) \
        __builtin_amdgcn_global_load_lds((const unsigned*)((const char*)(gbase) + (voff)[_i]), (PG8_LAS unsigned*)(lds + (bufoff) + ldsw + _i * 8192), 16, 0, 0); } while (0)
#define PG8_LDA(dst, b, h) do { _Pragma("unroll") for (int m = 0; m < 4; ++m) _Pragma("unroll") for (int k = 0; k < 2; ++k) dst[m][k] = *(const PG8_LAS h8*)(lds + PG8_SA(b, h) + aoff + m * 2048 + k * 1024); } while (0)
#define PG8_LDB(dst, b, h) do { _Pragma("unroll") for (int n = 0; n < 2; ++n) _Pragma("unroll") for (int k = 0; k < 2; ++k) dst[n][k] = *(const PG8_LAS h8*)(lds + PG8_SB(b, h) + boff + n * 2048 + k * 1024); } while (0)
#define PG8_MMA(ai, bj, At, Bt) do { __builtin_amdgcn_s_setprio(1); _Pragma("unroll") for (int m = 0; m < 4; ++m) _Pragma("unroll") for (int n = 0; n < 2; ++n) _Pragma("unroll") for (int k = 0; k < 2; ++k) \
        acc[ai][bj][m][n] = __builtin_amdgcn_mfma_f32_16x16x32_f16(Bt[n][k], At[m][k], acc[ai][bj][m][n], 0, 0, 0); __builtin_amdgcn_s_setprio(0); } while (0)
#define PG8_WAIT_V(n) asm volatile("s_waitcnt vmcnt(" #n ")" ::: "memory")
#define PG8_WAIT_L(n) asm volatile("s_waitcnt lgkmcnt(" #n ")" ::: "memory")
#define PG8_BAR __builtin_amdgcn_s_barrier()
#define PG8_SCHED __builtin_amdgcn_sched_barrier(0)
    Unit cur, nxt; int ui = 0;
    if (!S.next(0, cur)) return;
    f32x4 acc[2][2][4][2];
    float z0_ = zf();
#pragma unroll
    for (int a = 0; a < 2; ++a)
#pragma unroll
        for (int b = 0; b < 2; ++b)
#pragma unroll
            for (int m = 0; m < 4; ++m)
#pragma unroll
                for (int n = 0; n < 2; ++n) acc[a][b][m][n] = (f32x4){z0_, z0_, z0_, z0_};
    h8 At[4][2], B0[2][2], B1[2][2];
    const char* cA = (const char*)g.A + (size_t)cur.pm * tstep; const char* cB = (const char*)g.Bt + (size_t)cur.pn * tstep;
    S.a_ready(cur);
    if constexpr (SP2) {
        PG8_STAGE(PG8_SB(0, 0), cB, voffB); PG8_STAGE(PG8_SB(0, 1), cB + hstep, voffB); PG8_STAGE(PG8_SA(0, 0), cA, voffA); PG8_STAGE(PG8_SA(0, 1), cA + hstep, voffA);
        if (wr == 1) PG8_BAR;
        PG8_WAIT_V(2); PG8_BAR;
        PG8_STAGE(PG8_SB(1, 0), cB + kstep, voffB); PG8_STAGE(PG8_SA(1, 0), cA + kstep, voffA); PG8_STAGE(PG8_SB(1, 1), cB + hstep + kstep, voffB);
        PG8_WAIT_V(6); PG8_BAR;
    } else {
        PG8_STAGE(PG8_SB(0, 0), cB, voffB); PG8_STAGE(PG8_SA(0, 0), cA, voffA); PG8_STAGE(PG8_SB(0, 1), cB + hstep, voffB); PG8_STAGE(PG8_SA(0, 1), cA + hstep, voffA);
        if (wr == 1) PG8_BAR;
        PG8_WAIT_V(4); PG8_BAR;
        PG8_STAGE(PG8_SB(1, 0), cB + kstep, voffB); PG8_STAGE(PG8_SA(1, 0), cA + kstep, voffA); PG8_STAGE(PG8_SB(1, 1), cB + hstep + kstep, voffB);
        PG8_WAIT_V(6); PG8_BAR;
    }
    for (;;) {
        const bool has_next = S.next(ui + 1, nxt);
        const char* nA = has_next ? (const char*)g.A + (size_t)nxt.pm * tstep : cA; const char* nB = has_next ? (const char*)g.Bt + (size_t)nxt.pn * tstep : cB;
        for (int t = 0; t < nt; t += 2) {
            const bool last = (t == nt - 2);
            const char* a1 = cA + (size_t)(t + 1) * kstep;
            const char* a2 = last ? nA : cA + (size_t)(t + 2) * kstep; const char* b2 = last ? nB : cB + (size_t)(t + 2) * kstep;
            const char* a3 = a2 + kstep; const char* b3 = b2 + kstep;
            if (last && has_next) S.a_ready(nxt);
            if constexpr (SP2) {
            PG8_LDB(B0, 0, 0); PG8_LDB(B1, 0, 1); PG8_SCHED; PG8_LDA(At, 0, 0); PG8_STAGE(PG8_SA(1, 1), a1 + hstep, voffA);
            PG8_WAIT_V(8); PG8_WAIT_L(0); PG8_BAR; PG8_MMA(0, 0, At, B0); PG8_MMA(0, 1, At, B1); PG8_BAR; PG8_SCHED;
            PG8_LDA(At, 0, 1); PG8_STAGE(PG8_SB(0, 0), b2, voffB); PG8_STAGE(PG8_SB(0, 1), b2 + hstep, voffB); PG8_STAGE(PG8_SA(0, 0), a2, voffA);
            PG8_WAIT_V(8); PG8_WAIT_L(0); PG8_BAR; PG8_MMA(1, 0, At, B0); PG8_MMA(1, 1, At, B1); PG8_BAR; PG8_SCHED;
            PG8_LDB(B0, 1, 0); PG8_LDB(B1, 1, 1); PG8_SCHED; PG8_LDA(At, 1, 0); PG8_STAGE(PG8_SA(0, 1), a2 + hstep, voffA);
            PG8_WAIT_V(8); PG8_WAIT_L(0); PG8_BAR; PG8_MMA(0, 0, At, B0); PG8_MMA(0, 1, At, B1); PG8_BAR; PG8_SCHED;
            PG8_LDA(At, 1, 1); PG8_STAGE(PG8_SB(1, 0), b3, voffB); PG8_STAGE(PG8_SB(1, 1), b3 + hstep, voffB); PG8_STAGE(PG8_SA(1, 0), a3, voffA);
            PG8_WAIT_V(8); PG8_WAIT_L(0); PG8_BAR; PG8_MMA(1, 0, At, B0); PG8_MMA(1, 1, At, B1); PG8_BAR; PG8_SCHED;
            } else {
            PG8_LDB(B0, 0, 0); PG8_SCHED; PG8_LDA(At, 0, 0); PG8_STAGE(PG8_SA(1, 1), a1 + hstep, voffA);
            PG8_WAIT_L(8); PG8_BAR; PG8_WAIT_L(0); PG8_MMA(0, 0, At, B0); PG8_BAR; PG8_SCHED;
            PG8_LDB(B1, 0, 1); PG8_STAGE(PG8_SB(0, 0), b2, voffB);
            PG8_BAR; PG8_WAIT_L(0); PG8_MMA(0, 1, At, B1); PG8_BAR;
            PG8_LDA(At, 0, 1); PG8_STAGE(PG8_SA(0, 0), a2, voffA);
            PG8_BAR; PG8_WAIT_L(0); PG8_MMA(1, 0, At, B0); PG8_BAR; PG8_SCHED;
            PG8_STAGE(PG8_SB(0, 1), b2 + hstep, voffB);
            PG8_WAIT_V(6); PG8_BAR; PG8_MMA(1, 1, At, B1); PG8_BAR;
            PG8_LDB(B0, 1, 0); PG8_SCHED; PG8_LDA(At, 1, 0); PG8_STAGE(PG8_SA(0, 1), a2 + hstep, voffA);
            PG8_WAIT_L(8); PG8_BAR; PG8_WAIT_L(0); PG8_MMA(0, 0, At, B0); PG8_BAR; PG8_SCHED;
            PG8_LDB(B1, 1, 1); PG8_STAGE(PG8_SB(1, 0), b3, voffB);
            PG8_BAR; PG8_WAIT_L(0); PG8_MMA(0, 1, At, B1); PG8_BAR;
            PG8_LDA(At, 1, 1); PG8_STAGE(PG8_SA(1, 0), a3, voffA);
            PG8_BAR; PG8_WAIT_L(0); PG8_MMA(1, 0, At, B0); PG8_BAR; PG8_SCHED;
            PG8_STAGE(PG8_SB(1, 1), b3 + hstep, voffB);
            PG8_WAIT_V(6); PG8_BAR; PG8_MMA(1, 1, At, B1); PG8_BAR;
            }
        }
        if constexpr (ALIGN_EPI) { if (wr == 0) PG8_BAR; }
        if constexpr (!Epi::AFTER_DRAIN) { E(acc, cur, wr, wc, fr, fq); S.done(cur); }
        if (!has_next) break;
        z0_ = zf();
#pragma unroll
        for (int a = 0; a < 2; ++a)
#pragma unroll
            for (int b = 0; b < 2; ++b)
#pragma unroll
                for (int m = 0; m < 4; ++m)
#pragma unroll
                    for (int n = 0; n < 2; ++n) acc[a][b][m][n] = (f32x4){z0_, z0_, z0_, z0_};
        cur = nxt; cA = nA; cB = nB; ++ui;
        if constexpr (ALIGN_EPI) { if (wr == 1) PG8_BAR; }
    }
    PG8_WAIT_V(0);
    if constexpr (!ALIGN_EPI) { if (wr == 0) PG8_BAR; }
    PG8_BAR;
    if constexpr (Epi::AFTER_DRAIN) { E.fused(acc, cur, wr, wc, fr, fq, lds, wid, lane); S.done(cur); }
#undef PG8_SA
#undef PG8_SB
#undef PG8_STAGE
#undef PG8_LDA
#undef PG8_LDB
#undef PG8_MMA
#undef PG8_WAIT_V
#undef PG8_WAIT_L
#undef PG8_BAR
#undef PG8_SCHED
}
}

namespace epi {
using pg8::Unit; using pg8::BM; using pg8::HALF;
typedef f32x4 Acc[2][2][4][2];
constexpr int SROW_OFF = MISC_OFF + 128, SROW_MAX_UNITS = 15;
static_assert(SROW_OFF + SROW_MAX_UNITS * 1024 <= LDS_BYTES, "row-scale table fits the LDS reservation");

template <int NP> __device__ __forceinline__ float row_ss(const float* P, int row) {
    if constexpr (NP == 1) return P[row];
    else { float s = 0.f;
#pragma unroll
        for (int i = 0; i < NP / 4; ++i) { const f32x4 v = *(const f32x4*)(P + (size_t)row * NP + 4 * i); s += (v[0] + v[1]) + (v[2] + v[3]); }
        return s; }
}
__device__ __forceinline__ float rs_from(float ss, float inv_dim) { return 1.0f / sqrtf(ss * inv_dim + EPS); }
template <class Sched> __device__ __forceinline__ void prep_srow(LAS unsigned char* lds, const float* SS, const Sched& So, int tid) {
    LAS float* tab = (LAS float*)(lds + SROW_OFF);
    Unit u;
    for (int i = 0; i < SROW_MAX_UNITS; ++i) { if (!So.next(i, u)) break;
        if (tid < 256) { const int row = u.pm * BM + tid; tab[i * 256 + tid] = rs_from(row_ss<16>(SS, row), 1.0f / 1024.0f); } }
    __syncthreads();
}
__device__ __forceinline__ void st8(half_t* p, f32x4 a, f32x4 b, float s) {
    u32x4 w; w.x = pkh(a[0] * s, a[1] * s); w.y = pkh(a[2] * s, a[3] * s); w.z = pkh(b[0] * s, b[1] * s); w.w = pkh(b[2] * s, b[3] * s);
    *(u32x4*)p = w;
}
__device__ __forceinline__ void st4(half_t* p, f32x4 a) { u32x2 w; w.x = pkh(a[0], a[1]); w.y = pkh(a[2], a[3]); *(u32x2*)p = w; }
__device__ __forceinline__ void rope_st(half_t* p1, half_t* p2, f32x4 x1, f32x4 x2, float s, const float* ctab, const float* stab) {
    const f32x4 c = *(const f32x4*)ctab, sn = *(const f32x4*)stab;
    x1 = x1 * s; x2 = x2 * s;
    st4(p1, x1 * c - x2 * sn); st4(p2, x2 * c + x1 * sn);
}

template <int XM = 0> struct EpiUpT {
    static constexpr bool PERM = false, AFTER_DRAIN = false;
    unsigned char* ws; LAS unsigned char* lds;
    __device__ __forceinline__ void operator()(const Acc& acc, const Unit& u_, int wr, int wc, int fr, int fq) const {
        Unit u = u_; asm volatile("" : "+s"(u.pm), "+s"(u.pn), "+s"(u.ord)); { int ln_; asm volatile("v_mbcnt_lo_u32_b32 %0, -1, 0\n\tv_mbcnt_hi_u32_b32 %0, -1, %0" : "=v"(ln_)); fr = ln_ & 15; fq = ln_ >> 4; }
        half_t* H = (half_t*)(ws + (XM ? WS_END : WS_HID)); if (XM) u.pm = 0; const LAS float* stab = (const LAS float*)(lds + SROW_OFF) + u.ord * 256;
#pragma unroll
        for (int ai = 0; ai < 2; ++ai)
#pragma unroll
            for (int m = 0; m < 4; ++m) {
                const int row = u.pm * BM + ai * HALF + wr * 64 + m * 16 + fr;
                const float s = stab[ai * HALF + wr * 64 + m * 16 + fr];
                float v[8];
#pragma unroll
                for (int n = 0; n < 2; ++n)
#pragma unroll
                    for (int j = 0; j < 4; ++j) {
                        const float g = acc[ai][0][m][n][j] * s, up = acc[ai][1][m][n][j] * s;
                        v[4 * n + j] = (XM == 2 || XM == 3 || XM == 5) ? g * up : g * __builtin_amdgcn_rcpf(1.0f + __expf(-g)) * up;
                    }
                u32x4 w; w.x = pkh(v[0], v[1]); w.y = pkh(v[2], v[3]); w.z = pkh(v[4], v[5]); w.w = pkh(v[6], v[7]);
                if (XM != 5 || w.x == 0x12345678u) *(u32x4*)(H + (size_t)row * DFF + 128 * u.pn + 32 * wc + 8 * fq) = w;
            }
    }
};

typedef EpiUpT<0> EpiUp;

struct EpiRes {
    static constexpr bool PERM = false, AFTER_DRAIN = false;
    unsigned char* ws; float alpha;
    __device__ __forceinline__ void operator()(const Acc& acc, const Unit& u_, int wr, int wc, int fr, int fq) const {
        Unit u = u_; asm volatile("" : "+s"(u.pm), "+s"(u.pn), "+s"(u.ord)); { int ln_; asm volatile("v_mbcnt_lo_u32_b32 %0, -1, 0\n\tv_mbcnt_hi_u32_b32 %0, -1, %0" : "=v"(ln_)); fr = ln_ & 15; fq = ln_ >> 4; }
        half_t* XN = (half_t*)(ws + WS_XN); float* SS = (float*)(ws + WS_SS);
#pragma unroll
        for (int ai = 0; ai < 2; ++ai) {
            h8 xo[4][2];
#pragma unroll
            for (int m = 0; m < 4; ++m)
#pragma unroll
                for (int bj = 0; bj < 2; ++bj)
                    xo[m][bj] = *(const h8*)(XN + (size_t)(u.pm * BM + ai * HALF + wr * 64 + m * 16 + fr) * D + u.pn * BM + bj * HALF + 32 * wc + 8 * fq);
            asm volatile("" ::: "memory");
#pragma unroll
            for (int m = 0; m < 4; ++m) {
                const int row = u.pm * BM + ai * HALF + wr * 64 + m * 16 + fr;
                float q = 0.f;
#pragma unroll
                for (int bj = 0; bj < 2; ++bj) {
                    half_t* p = XN + (size_t)row * D + u.pn * BM + bj * HALF + 32 * wc + 8 * fq;
                    float x[8];
#pragma unroll
                    for (int j = 0; j < 4; ++j) { x[j] = (float)xo[m][bj][j] + acc[ai][bj][m][0][j] * alpha; x[4 + j] = (float)xo[m][bj][4 + j] + acc[ai][bj][m][1][j] * alpha; }
                    u32x4 w; w.x = pkh(x[0], x[1]); w.y = pkh(x[2], x[3]); w.z = pkh(x[4], x[5]); w.w = pkh(x[6], x[7]);
                    *(u32x4*)p = w;
                    const h8 xr = __builtin_bit_cast(h8, w);
#pragma unroll
                    for (int j = 0; j < 8; ++j) { const float v = (float)xr[j]; q = __builtin_fmaf(v, v, q); }
                }
                { const int ln_ = fr + 16 * fq; q += bperm_f(ln_ ^ 16, q); q += bperm_f(ln_ ^ 32, q); }
                if (fq == 0) SS[(size_t)row * 16 + 4 * u.pn + wc] = q;
            }
            asm volatile("" ::: "memory");
        }
    }
};

template <int NP> struct EpiScale {
    static constexpr bool PERM = false, AFTER_DRAIN = false;
    unsigned char* ws; LAS unsigned char* lds; size_t o_off, p_off; int ldo; float inv_dim, cscale;
    __device__ __forceinline__ void operator()(const Acc& acc, const Unit& u_, int wr, int wc, int fr, int fq) const {
        Unit u = u_; asm volatile("" : "+s"(u.pm), "+s"(u.pn), "+s"(u.ord)); { int ln_; asm volatile("v_mbcnt_lo_u32_b32 %0, -1, 0\n\tv_mbcnt_hi_u32_b32 %0, -1, %0" : "=v"(ln_)); fr = ln_ & 15; fq = ln_ >> 4; }
        half_t* O = (half_t*)(ws + o_off); const float* P = (const float*)(ws + p_off);
#pragma unroll
        for (int ai = 0; ai < 2; ++ai)
#pragma unroll
            for (int m = 0; m < 4; ++m) {
                const int row = u.pm * BM + ai * HALF + wr * 64 + m * 16 + fr;
                const float s = (NP == 16 ? ((const LAS float*)(lds + SROW_OFF))[u.ord * 256 + ai * HALF + wr * 64 + m * 16 + fr] : rs_from(row_ss<NP>(P, row), inv_dim)) * cscale;
#pragma unroll
                for (int bj = 0; bj < 2; ++bj) st8(O + (size_t)row * ldo + u.pn * BM + bj * HALF + 32 * wc + 8 * fq, acc[ai][bj][m][0], acc[ai][bj][m][1], s);
            }
    }
};

struct EpiUq {
    static constexpr bool PERM = false, AFTER_DRAIN = false;
    unsigned char* ws;
    __device__ __forceinline__ void operator()(const Acc& acc, const Unit& u_, int wr, int wc, int fr, int fq) const {
        Unit u = u_; asm volatile("" : "+s"(u.pm), "+s"(u.pn), "+s"(u.ord)); { int ln_; asm volatile("v_mbcnt_lo_u32_b32 %0, -1, 0\n\tv_mbcnt_hi_u32_b32 %0, -1, %0" : "=v"(ln_)); fr = ln_ & 15; fq = ln_ >> 4; }
        half_t* QUP = (half_t*)(ws + WS_QUP); const float* SSQ = (const float*)(ws + WS_SSQ);
        const float* COS16 = (const float*)(ws + WS_TAB); const float* SIN16 = COS16 + 2048 * 16;
        const float cs = 0.10206207261596575f * LOG2E;
#pragma unroll
        for (int bj = 0; bj < 2; ++bj) {
            const int g = 8 * u.pn + 4 * bj + wc;
            if (g >= 18) continue;
            const int head = g / 3, part = g - 3 * head;
#pragma unroll
            for (int ai = 0; ai < 2; ++ai)
#pragma unroll
                for (int m = 0; m < 4; ++m) {
                    const int row = u.pm * BM + ai * HALF + wr * 64 + m * 16 + fr;
                    const float s = rs_from(row_ss<4>(SSQ, row), 1.0f / 256.0f) * cs;
                    half_t* rp = QUP + (size_t)row * 576 + 96 * head;
                    if (part < 2) st8(rp + 32 * part + 8 * fq, acc[ai][bj][m][0], acc[ai][bj][m][1], s);
                    else { const int pos = row & (S - 1);
                        rope_st(rp + 64 + 4 * fq, rp + 80 + 4 * fq, acc[ai][bj][m][0], acc[ai][bj][m][1], s, COS16 + pos * 16 + 4 * fq, SIN16 + pos * 16 + 4 * fq); }
                }
        }
    }
};

struct EpiWin {
    static constexpr bool PERM = false, AFTER_DRAIN = false;
    unsigned char* ws; LAS unsigned char* lds;
    __device__ __forceinline__ void operator()(const Acc& acc, const Unit& u_, int wr, int wc, int fr, int fq) const {
        Unit u = u_; asm volatile("" : "+s"(u.pm), "+s"(u.pn), "+s"(u.ord)); { int ln_; asm volatile("v_mbcnt_lo_u32_b32 %0, -1, 0\n\tv_mbcnt_hi_u32_b32 %0, -1, %0" : "=v"(ln_)); fr = ln_ & 15; fq = ln_ >> 4; }
        const LAS float* stab = (const LAS float*)(lds + SROW_OFF) + u.ord * 256;
        half_t *QF = (half_t*)(ws + WS_QF), *KF = (half_t*)(ws + WS_KF), *VF = (half_t*)(ws + WS_VF), *MCQ = (half_t*)(ws + WS_MCQ), *MCKV = (half_t*)(ws + WS_MCKV), *DQ = (half_t*)(ws + WS_DQ),
               *DK = (half_t*)(ws + WS_DK), *DV = (half_t*)(ws + WS_DV), *DQI = (half_t*)(ws + WS_DQI), *DKI = (half_t*)(ws + WS_DKI), *KR = (half_t*)(ws + WS_KR);
        float *SMALL = (float*)(ws + WS_SMALL), *SSQ = (float*)(ws + WS_SSQ), *SSKV = (float*)(ws + WS_SSKV);
        const float* COS16 = (const float*)(ws + WS_TAB); const float *SIN16 = COS16 + 2048 * 16, *COS32 = COS16 + 2048 * 32, *SIN32 = COS16 + 2048 * 64;
        const float cq = 0.125f * LOG2E;
        float s8[2][4];
#pragma unroll
        for (int ai = 0; ai < 2; ++ai)
#pragma unroll
            for (int m = 0; m < 4; ++m) s8[ai][m] = stab[ai * HALF + wr * 64 + m * 16 + fr];
        const int rbase = u.pm * BM + wr * 64 + fr;
#define ROWS_BEGIN _Pragma("unroll") for (int ai = 0; ai < 2; ++ai) _Pragma("unroll") for (int m = 0; m < 4; ++m) { const int row = rbase + ai * HALF + m * 16; const float s = s8[ai][m]; (void)s;
#define ROWS_END asm volatile("" ::: "memory"); }
#define PLAIN(BJ, DST, LD, COL, SC) ROWS_BEGIN st8((DST) + (size_t)row * (LD) + (COL) + 8 * fq, acc[ai][BJ][m][0], acc[ai][BJ][m][1], s * (SC)); ROWS_END
        const int pn = u.pn;
        if (pn == 0) { PLAIN(0, QF, 384, 32 * wc, cq) PLAIN(1, QF, 384, 128 + 32 * wc, cq) }
        else if (pn == 1) { PLAIN(0, QF, 384, 256 + 32 * wc, cq) PLAIN(1, KF, 384, 32 * wc, 1.0f) }
        else if (pn == 2) { PLAIN(0, KF, 384, 128 + 32 * wc, 1.0f) PLAIN(1, KF, 384, 256 + 32 * wc, 1.0f) }
        else if (pn == 3) { PLAIN(0, VF, 384, 32 * wc, 1.0f) PLAIN(1, VF, 384, 128 + 32 * wc, 1.0f) }
        else if (pn == 4) {
            PLAIN(0, VF, 384, 256 + 32 * wc, 1.0f)
            ROWS_BEGIN
                const f32x4 a = acc[ai][1][m][0] * s, b = acc[ai][1][m][1] * s;
                st8(MCKV + (size_t)row * 128 + 32 * wc + 8 * fq, a, b, 1.0f);
                float q = (a[0] * a[0] + a[1] * a[1]) + (a[2] * a[2] + a[3] * a[3]) + (b[0] * b[0] + b[1] * b[1]) + (b[2] * b[2] + b[3] * b[3]);
                { const int ln_ = fr + 16 * fq; q += bperm_f(ln_ ^ 16, q); q += bperm_f(ln_ ^ 32, q); }
                if (fq == 0) SSKV[(size_t)row * 4 + wc] = q;
            ROWS_END
        } else if (pn == 5) {
            ROWS_BEGIN
                float q = 0.f;
#pragma unroll
                for (int bj = 0; bj < 2; ++bj) {
                    const f32x4 a = acc[ai][bj][m][0] * s, b = acc[ai][bj][m][1] * s;
                    st8(MCQ + (size_t)row * 256 + 128 * bj + 32 * wc + 8 * fq, a, b, 1.0f);
                    q += (a[0] * a[0] + a[1] * a[1]) + (a[2] * a[2] + a[3] * a[3]) + (b[0] * b[0] + b[1] * b[1]) + (b[2] * b[2] + b[3] * b[3]);
                }
                { const int ln_ = fr + 16 * fq; q += bperm_f(ln_ ^ 16, q); q += bperm_f(ln_ ^ 32, q); }
                if (fq == 0) SSQ[(size_t)row * 4 + wc] = q;
            ROWS_END
        } else if (pn == 6) {
            const int e1 = 16 * (wc & 1) + 4 * fq;
            ROWS_BEGIN
                const int pos = row & (S - 1);
                const f32x4 c = *(const f32x4*)(COS32 + pos * 32 + e1), sn = *(const f32x4*)(SIN32 + pos * 32 + e1);
#pragma unroll
                for (int bj = 0; bj < 2; ++bj) {
                    half_t* rp = DQ + (size_t)row * 256 + 64 * ((4 * bj + wc) >> 1) + e1;
                    const f32x4 x1 = acc[ai][bj][m][0] * (s * cq), x2 = acc[ai][bj][m][1] * (s * cq);
                    st4(rp, x1 * c - x2 * sn); st4(rp + 32, x2 * c + x1 * sn);
                }
            ROWS_END
        } else if (pn == 7) {
            ROWS_BEGIN
                const int pos = row & (S - 1);
                const f32x4 c = *(const f32x4*)(COS16 + pos * 16 + 4 * fq), sn = *(const f32x4*)(SIN16 + pos * 16 + 4 * fq);
#pragma unroll
                for (int bj = 0; bj < 2; ++bj) {
                    half_t* rp = DQI + (size_t)row * 256 + 32 * (4 * bj + wc) + 4 * fq;
                    const f32x4 x1 = acc[ai][bj][m][0] * s, x2 = acc[ai][bj][m][1] * s;
                    st4(rp, x1 * c - x2 * sn); st4(rp + 16, x2 * c + x1 * sn);
                }
            ROWS_END
        } else {
            if (wc < 2) { const int e1 = 16 * wc + 4 * fq;
                ROWS_BEGIN
                    const int pos = row & (S - 1); half_t* rp = DK + (size_t)row * 64 + e1;
                    rope_st(rp, rp + 32, acc[ai][0][m][0], acc[ai][0][m][1], s, COS32 + pos * 32 + e1, SIN32 + pos * 32 + e1);
                ROWS_END
            } else { PLAIN(0, DV, 64, 32 * (wc - 2), 1.0f) }
            if (wc < 2) { half_t* dst = wc == 0 ? KR : DKI;
                ROWS_BEGIN
                    const int pos = row & (S - 1); half_t* rp = dst + (size_t)row * 32 + 4 * fq;
                    rope_st(rp, rp + 16, acc[ai][1][m][0], acc[ai][1][m][1], s, COS16 + pos * 16 + 4 * fq, SIN16 + pos * 16 + 4 * fq);
                ROWS_END
            } else if (wc == 2) {
                ROWS_BEGIN
                    *(f32x4*)(SMALL + (size_t)row * 16 + 4 * fq) = acc[ai][1][m][0] * s;
                ROWS_END
            }
        }
#undef PLAIN
#undef ROWS_BEGIN
#undef ROWS_END
    }
};
}

struct Args { const float* in[22]; float* out; unsigned char* ws; };
typedef __attribute__((address_space(4))) const Args CArgs;
__device__ __forceinline__ CArgs* kargs() { CArgs* p = (CArgs*)__builtin_amdgcn_kernarg_segment_ptr(); asm volatile("" : "+s"(p)); return p; }
struct Frame {
    LAS unsigned char* lds;
    volatile LAS unsigned* MISC;
    gu32* ctl;
    unsigned char* ws;
    int tid, lane, wave, vcu, G;
};
enum { I_X = 0, I_MEM, I_F1N, I_F1WI, I_F1WO, I_MIXN, I_WIN, I_BF, I_QN, I_WUQ, I_KVN, I_WUKV, I_WOUT, I_XAN, I_MEMN, I_XWQ, I_XWKV, I_XWO, I_F2N, I_F2WI, I_F2WO, I_FINN };

__device__ __forceinline__ half_t* wl_ptr(unsigned char* ws, int layer, size_t off) { return (half_t*)(ws + WS_W + (size_t)layer * WL_STRIDE + off); }

__device__ __forceinline__ int src_perm(int nb) { return (nb & ~31) + perm32(nb & 31); }
__device__ __forceinline__ int src_swiglu(int nb) { const int pn = nb >> 8, bj = (nb >> 7) & 1, wc = (nb >> 5) & 3; return bj * DFF + 128 * pn + 32 * wc + perm32(nb & 31); }
__device__ __forceinline__ int src_uq(int nb) { const int g = nb >> 5, rho = nb & 31; if (g >= 18) return -1; return (g % 3 == 2) ? 32 * g + rho : 32 * g + perm32(rho); }
__device__ __forceinline__ int src_win(int nb) {
    const int g = nb >> 5, rho = nb & 31, p = perm32(rho), r64 = (rho & 15) + 32 * (rho >> 4);
    if (g < 12) return C_FQ + 32 * g + p;
    if (g < 24) return C_FK + 32 * (g - 12) + p;
    if (g < 36) return C_FV + 32 * (g - 24) + p;
    if (g < 40) return C_MCKV + 32 * (g - 36) + p;
    if (g < 48) return C_MCQ + 32 * (g - 40) + p;
    if (g < 56) return C_DQ + 64 * ((g - 48) >> 1) + 16 * ((g - 48) & 1) + r64;
    if (g < 64) return C_DQI + 32 * (g - 56) + rho;
    if (g < 66) return C_DK + 16 * (g - 64) + r64;
    if (g < 68) return C_DV + 32 * (g - 66) + p;
    if (g == 68) return C_MKR + rho;
    if (g == 69) return C_DKI + rho;
    if (g == 70) return rho < 6 ? C_FF + rho : (rho >= 8 && rho < 16) ? C_DWI + rho - 8 : -1;
    return -1;
}
struct ConvDesc { const float* W; const float* gain; half_t* Bt; int ldw, K, nblk, map; };
__device__ __forceinline__ void conv_desc(CArgs* A, unsigned char* ws, int it, ConvDesc& d, int& r_out) {
    constexpr int I_WI = 16 * 176, I_WO = 44 * 32, I_WINN = 16 * 72, I_UQ = 4 * 24, I_UKV = 2 * 24, I_OUT = 16 * 32, I_XQ = 16 * 16, I_XKV = 16 * 32, I_XO = 8 * 32;
    constexpr int PER_LAYER = 2 * I_WI + 2 * I_WO + I_WINN + I_UQ + I_UKV + I_OUT + I_XQ + I_XKV + I_XO;
    const int l = it / PER_LAYER; int r = it - l * PER_LAYER;
    int map = 0, iw = 0, ig = -1, ldw = 0, K = 0, nblk = 0; size_t woff = 0, wl = 0, goff = 0;
    if (r < I_WI) { map = 1; iw = I_F1WI; ig = I_F1N; ldw = 2 * DFF; K = D; nblk = 176; woff = (size_t)l * D * 2 * DFF; wl = WL_WI1; goff = l * D; }
    else if ((r -= I_WI) < I_WO) { iw = I_F1WO; ldw = D; K = DFF; nblk = 32; woff = (size_t)l * DFF * D; wl = WL_WO1; }
    else if ((r -= I_WO) < I_WINN) { map = 2; iw = I_WIN; ig = I_MIXN; ldw = DIN; K = D; nblk = 72; woff = (size_t)l * D * DIN; wl = WL_WIN; goff = l * D; }
    else if ((r -= I_WINN) < I_UQ) { map = 3; iw = I_WUQ; ig = I_QN; ldw = 576; K = 256; nblk = 24; woff = (size_t)l * 256 * 576; wl = WL_WUQ; goff = l * 256; }
    else if ((r -= I_UQ) < I_UKV) { iw = I_WUKV; ig = I_KVN; ldw = 768; K = 128; nblk = 24; woff = (size_t)l * 128 * 768; wl = WL_WUKV; goff = l * 128; }
    else if ((r -= I_UKV) < I_OUT) { iw = I_WOUT; ldw = D; K = D; nblk = 32; woff = (size_t)l * D * D; wl = WL_WOUT; }
    else if ((r -= I_OUT) < I_XQ) { iw = I_XWQ; ig = I_XAN; ldw = 512; K = D; nblk = 16; woff = (size_t)l * D * 512; wl = WL_XWQ; goff = l * D; }
    else if ((r -= I_XQ) < I_XKV) { iw = I_XWKV; ig = I_MEMN; ldw = 1024; K = D; nblk = 32; woff = (size_t)l * D * 1024; wl = WL_XWKV; goff = l * D; }
    else if ((r -= I_XKV) < I_XO) { iw = I_XWO; ldw = D; K = 512; nblk = 32; woff = (size_t)l * 512 * D; wl = WL_XWO; }
    else if ((r -= I_XO) < I_WI) { map = 1; iw = I_F2WI; ig = I_F2N; ldw = 2 * DFF; K = D; nblk = 176; woff = (size_t)l * D * 2 * DFF; wl = WL_WI2; goff = l * D; }
    else { r -= I_WI; iw = I_F2WO; ldw = D; K = DFF; nblk = 32; woff = (size_t)l * DFF * D; wl = WL_WO2; }
    d.W = A->in[iw] + woff; d.gain = ig >= 0 ? A->in[ig] + goff : nullptr; d.Bt = wl_ptr(ws, l, wl); d.ldw = ldw; d.K = K; d.nblk = nblk; d.map = map; r_out = r;
}
__device__ __forceinline__ void conv_load(const ConvDesc& d, int item, int lane, float (&v)[32]) {
    const int kb = item / d.nblk, nb = item % d.nblk, k0 = 64 * kb, n0 = 32 * nb;
    const int nbrow = n0 + (lane & 31);
    const int sc = d.map == 0 ? src_perm(nbrow) : d.map == 1 ? src_swiglu(nbrow) : d.map == 2 ? src_win(nbrow) : src_uq(nbrow);
    const float* wp = d.W + (size_t)(k0 + (lane >> 5)) * d.ldw + (sc >= 0 ? sc : 0);
#pragma unroll
    for (int i = 0; i < 32; ++i) v[i] = wp[(size_t)(2 * i) * d.ldw];
    if (d.gain) {
        const float* gp = d.gain + k0 + (lane >> 5);
        float g[32];
#pragma unroll
        for (int i = 0; i < 32; ++i) g[i] = gp[2 * i];
#pragma unroll
        for (int i = 0; i < 32; ++i) v[i] *= g[i];
    }
    if (sc < 0) {
#pragma unroll
        for (int i = 0; i < 32; ++i) v[i] = 0.f;
    }
}
__device__ __forceinline__ void conv_store(const ConvDesc& d, int item, int lane, const float (&v)[32], LAS float* scr) {
    const int kb = item / d.nblk, nb = item % d.nblk, k0 = 64 * kb, n0 = 32 * nb;
#pragma unroll
    for (int i = 0; i < 32; ++i) scr[(2 * i + (lane >> 5)) * 33 + (lane & 31)] = v[i];
    LDS_WAIT(); asm volatile("" ::: "memory");
    const int c = lane & 7;
#pragma unroll
    for (int j = 0; j < 4; ++j) { const int n = (lane >> 3) + 8 * j; const LAS float* s = scr + (8 * c) * 33 + n;
        u32x4 o; o.x = pkh(s[0 * 33], s[1 * 33]); o.y = pkh(s[2 * 33], s[3 * 33]); o.z = pkh(s[4 * 33], s[5 * 33]); o.w = pkh(s[6 * 33], s[7 * 33]);
        *(GAS u32x4*)(d.Bt + (size_t)(n0 + n) * d.K + k0 + 8 * c) = o; }
    LDS_WAIT(); asm volatile("" ::: "memory");
}

template <int PARTS = 7> __device__ __forceinline__ void p0_prologue(Frame& F, CArgs* A) {
    LAS float* scr = (LAS float*)(F.lds + F.wave * 16384);
    const int gw = F.vcu * NWAVES + F.wave, NGW = F.G * NWAVES;
    if (PARTS & 1) {
        constexpr int NITEMS = 2 * (2 * 16 * 176 + 2 * 44 * 32 + 16 * 72 + 4 * 24 + 2 * 24 + 16 * 32 + 16 * 16 + 16 * 32 + 8 * 32);
        float va[32], vb[32]; ConvDesc da, db; int ra = 0, rb = 0;
        int it = gw;
        if (it < NITEMS) { conv_desc(A, F.ws, it, da, ra); conv_load(da, ra, F.lane, va); }
        while (it < NITEMS) {
            const int itb = it + NGW;
            if (itb < NITEMS) { conv_desc(A, F.ws, itb, db, rb); conv_load(db, rb, F.lane, vb); }
            conv_store(da, ra, F.lane, va, scr);
            if (itb >= NITEMS) break;
            const int ita = itb + NGW;
            if (ita < NITEMS) { conv_desc(A, F.ws, ita, da, ra); conv_load(da, ra, F.lane, va); }
            conv_store(db, rb, F.lane, vb, scr);
            it = ita;
        }
    }
    if (PARTS & 2) {
        float* tab = (float*)(F.ws + WS_TAB);
        float* COS16 = tab, *SIN16 = tab + 2048 * 16, *COS32 = tab + 2048 * 32, *SIN32 = tab + 2048 * 64;
        const int gt = F.vcu * NTHREADS + F.tid;
        if (gt < 2048 * 48) {
            const int pos = gt / 48, e = gt % 48;
            const int half = e < 16 ? 16 : 32, i = e < 16 ? e : e - 16;
            const float inv = powf(10000.0f, -(float)i / (float)half);
            const float ang = (float)pos * inv;
            const float c = cosf(ang), s = sinf(ang);
            if (e < 16) { COS16[pos * 16 + i] = c; SIN16[pos * 16 + i] = s; } else { COS32[pos * 32 + i] = c; SIN32[pos * 32 + i] = s; }
        }
    }
    if (PARTS & 4) for (int m0 = gw; m0 < M + MM; m0 += 4 * NGW) {
        f32x4 v[4][4]; float s[4] = {0.f, 0.f, 0.f, 0.f};
#pragma unroll
        for (int u = 0; u < 4; ++u) { const int m = m0 + u * NGW; if (m < M + MM) { const bool isx = m < M; const int r = isx ? m : m - M;
            const GAS f32x4* xr = (const GAS f32x4*)((isx ? A->in[I_X] : A->in[I_MEM]) + (size_t)r * D) + F.lane;
#pragma unroll
            for (int j = 0; j < 4; ++j) v[u][j] = xr[64 * j]; } }
#pragma unroll
        for (int u = 0; u < 4; ++u) { const int m = m0 + u * NGW; if (m < M + MM) { const bool isx = m < M; const int r = isx ? m : m - M;
            half_t* orow = (half_t*)(F.ws + (isx ? WS_XN : WS_MEMB)) + (size_t)r * D;
#pragma unroll
            for (int j = 0; j < 4; ++j) s[u] += (v[u][j].x * v[u][j].x + v[u][j].y * v[u][j].y) + (v[u][j].z * v[u][j].z + v[u][j].w * v[u][j].w);
            s[u] = wave_sum(s[u]);
#pragma unroll
            for (int j = 0; j < 4; ++j) { u32x2 w; w.x = pkh(v[u][j].x, v[u][j].y); w.y = pkh(v[u][j].z, v[u][j].w); *((GAS u32x2*)orow + F.lane + 64 * j) = w; }
            if (isx) { if (F.lane < 16) ((float*)(F.ws + WS_SS))[(size_t)r * 16 + F.lane] = F.lane == 0 ? s[u] : 0.f; }
            else if (F.lane == 0) ((float*)(F.ws + WS_MEMSS))[r] = s[u]; } }
    }
}

__device__ __forceinline__ float logsig(float z) { const float e = __builtin_amdgcn_exp2f(-__builtin_fabsf(z) * LOG2E); return fminf(z, 0.f) - __builtin_amdgcn_logf(1.0f + e) * 0.6931471805599453f; }
__device__ __forceinline__ void scan_seq(const float* SMALL, const float* bfg, float* CUM, int seq, int lane) {
    const int b = seq / 6, h = seq - 6 * b;
    const float* src = SMALL + ((size_t)b * S + 32 * lane) * 16 + h;
    const float bias = bfg[h];
    float v[32];
#pragma unroll
    for (int i = 0; i < 32; ++i) v[i] = src[i * 16];
    float run = 0.f;
#pragma unroll
    for (int i = 0; i < 32; ++i) { run += logsig(v[i] + bias); v[i] = run; }
    float inc = run;
#pragma unroll
    for (int o = 1; o < 64; o <<= 1) { const float t = bperm_f(lane >= o ? lane - o : lane, inc); if (lane >= o) inc += t; }
    const float off = inc - run;
    float* dst = CUM + (size_t)seq * S + 32 * lane;
#pragma unroll
    for (int i = 0; i < 8; ++i) { const f32x4 w = {(v[4 * i] + off) * LOG2E, (v[4 * i + 1] + off) * LOG2E, (v[4 * i + 2] + off) * LOG2E, (v[4 * i + 3] + off) * LOG2E}; *(f32x4*)(dst + 4 * i) = w; }
}

namespace dsa {
constexpr int QSTR = 1028  , HIST_BYTES = 16 * QSTR * 4;
constexpr int LIST_WORDS = 2048, STAGE_OFF = MISC_OFF + 128, STAGE_BYTES = 4096, QS_OFF = STAGE_OFF + STAGE_BYTES, FLAG_OFF = QS_OFF + 16 * 16, CNT_OFF = FLAG_OFF + 16, DUMMY_OFF = CNT_OFF + 64;
static_assert(DUMMY_OFF + 512 * 4 <= LDS_BYTES && 16 * LIST_WORDS * 4 <= RING_BYTES && HIST_BYTES <= RING_BYTES, "DSA threshold LDS map");
__device__ __forceinline__ unsigned fkey(float f) { const unsigned u = __float_as_uint(f); return u ^ ((unsigned)((int)u >> 31) | 0x80000000u); }

__device__ __forceinline__ unsigned comp_of(unsigned k, int s) { return ((k & 0x1FFFFFu) << 11) | (unsigned)(2047 - s); }

template <int PASS>
__device__ __forceinline__ void thr_pass(Frame& F, int qt, const unsigned (&key)[16][4], LAS unsigned* hist, LAS unsigned* stage, LAS unsigned* qs, LAS unsigned* flag) {
    int ln_; asm volatile("v_mbcnt_lo_u32_b32 %0, -1, 0\n\tv_mbcnt_hi_u32_b32 %0, -1, %0" : "=v"(ln_));
    const int lane = ln_, w = F.wave, tid = w * 64 + lane, qc = lane & 15, kg = lane >> 4;
    const unsigned D1 = qs[qc * 4 + 0], Cstar = qs[qc * 4 + 2];
    const unsigned hbase = (unsigned)(qc * QSTR) * 4u;
    LAS unsigned char* lb = (LAS unsigned char*)hist;
#pragma unroll
    for (int i = 0; i < 16; ++i) {
        const int kt = w + 8 * i;
        if (kt > qt) continue;
        unsigned nib = 0u;
#pragma unroll
        for (int j = 0; j < 4; ++j) {
            const unsigned k = key[i][j];
            const int s = 16 * kt + 4 * kg + j;
            if (PASS == 0) {
                const unsigned dg = k >> 21;
                __hip_atomic_fetch_add((LAS unsigned*)(lb + hbase + ((dg >> 1) << 2)), (dg & 1u) ? 0x10000u : 1u, __ATOMIC_RELAXED, __HIP_MEMORY_SCOPE_WORKGROUP);
            } else {
                const unsigned top = k >> 21;
                const bool sel = k != 0u && (top > D1 || (top == D1 && comp_of(k, s) >= Cstar));
                nib |= sel ? (1u << j) : 0u;
            }
        }
        if (PASS == 4) __hip_atomic_fetch_or(stage + qc * 64 + (kt >> 1), nib << (16 * (kt & 1) + 4 * kg), __ATOMIC_RELAXED, __HIP_MEMORY_SCOPE_WORKGROUP);
    }
    __syncthreads();
    if (PASS == 0) {
        const int q = tid >> 5, j = tid & 31, hb = lane & 32;
        const LAS unsigned* wd = hist + q * QSTR + 32 * j;
        unsigned cnt = 0u;
#pragma unroll
        for (int i = 0; i < 8; ++i) { const u32x4 x = *(const LAS u32x4*)(wd + 4 * i);
            cnt += (x.x & 0xffffu) + (x.x >> 16) + (x.y & 0xffffu) + (x.y >> 16) + (x.z & 0xffffu) + (x.z >> 16) + (x.w & 0xffffu) + (x.w >> 16); }
        if (j == 0) cnt -= (wd[0] & 0xffffu);
        unsigned inc = cnt;
#pragma unroll
        for (int o = 1; o < 32; o <<= 1) { const unsigned t = bperm_u(j + o < 32 ? lane + o : lane, inc); if (j + o < 32) inc += t; }
        const unsigned suf = inc - cnt, R = 256u;
        const bool isx = suf < R && suf + cnt >= R;
        const unsigned long long bal = __builtin_amdgcn_ballot_w64(isx);
        const unsigned hm = hb ? (unsigned)(bal >> 32) : (unsigned)bal;
        const int jstar = hm ? (int)__builtin_ctz(hm) : 0;
        const unsigned sufstar = bperm_u(hb + jstar, suf);
        const unsigned x = hist[q * QSTR + 32 * jstar + j], lo = (jstar == 0 && j == 0) ? 0u : (x & 0xffffu), hi = x >> 16, pc = lo + hi;
        unsigned inc2 = pc;
#pragma unroll
        for (int o = 1; o < 32; o <<= 1) { const unsigned t = bperm_u(j + o < 32 ? lane + o : lane, inc2); if (j + o < 32) inc2 += t; }
        const unsigned c = sufstar + (inc2 - pc);
        const bool hitHi = c < R && c + hi >= R;
        const bool hitLo = !hitHi && c + hi < R && c + hi + lo >= R;
        if (hm != 0u && (hitHi || hitLo)) { qs[q * 4 + 0] = 64 * jstar + 2 * j + (hitHi ? 1 : 0); qs[q * 4 + 1] = R - (hitHi ? c : c + hi); }
        __syncthreads();
    }
}

__device__ __forceinline__ void thr_select(Frame& F, int qt, const unsigned (&key)[16][4], LAS unsigned* list, LAS unsigned* qs, LAS unsigned* cnt) {
    int ln_; asm volatile("v_mbcnt_lo_u32_b32 %0, -1, 0\n\tv_mbcnt_hi_u32_b32 %0, -1, %0" : "=v"(ln_));
    const int lane = ln_, w = F.wave, qc = lane & 15, kg = lane >> 4;
    const unsigned D1 = qs[qc * 4 + 0];
    unsigned nc = 0u;
#pragma unroll
    for (int i = 0; i < 16; ++i) {
        if (w + 8 * i > qt) continue;
#pragma unroll
        for (int j = 0; j < 4; ++j) { const unsigned k = key[i][j]; nc += (k != 0u && (k >> 21) == D1) ? 1u : 0u; } }
    unsigned pos = 0u;
    if (nc != 0u) pos = __hip_atomic_fetch_add(cnt + qc, nc, __ATOMIC_RELAXED, __HIP_MEMORY_SCOPE_WORKGROUP);
    { LAS unsigned* lq = list + qc * LIST_WORDS;
#pragma unroll
      for (int i = 0; i < 16; ++i) {
          const int kt = w + 8 * i;
          if (kt > qt) continue;
#pragma unroll
          for (int j = 0; j < 4; ++j) {
              const unsigned k = key[i][j];
              if (k != 0u && (k >> 21) == D1) { lq[pos] = comp_of(k, 16 * kt + 4 * kg + j); ++pos; }
          }
      } }
    __syncthreads();
    const int q = 2 * w + (lane >> 5), j = lane & 31;
    const unsigned n = cnt[q], R = qs[q * 4 + 1];
    const LAS unsigned* lq = list + q * LIST_WORDS;
    unsigned e[8];
#pragma unroll
    for (int t = 0; t < 8; ++t) e[t] = (unsigned)(j + 32 * t) < n ? lq[j + 32 * t] : 0u;
    const unsigned nmax = (unsigned)__builtin_amdgcn_readfirstlane((int)max(n, bperm_u(lane ^ 32, n)));
    unsigned T = 0u, cT = n;
    const bool upper = (lane & 32) != 0;
    for (int bit = 31; bit >= 0; --bit) {
        if (__builtin_amdgcn_ballot_w64(cT != R && n != 0u) == 0ull) break;
        const unsigned cand = T | (1u << bit);
        unsigned ca = 0u, cb = 0u;
#pragma unroll
        for (int t = 0; t < 8; ++t) { const unsigned long long m = __builtin_amdgcn_ballot_w64(e[t] >= cand);
            ca += (unsigned)__builtin_popcount((unsigned)m); cb += (unsigned)__builtin_popcount((unsigned)(m >> 32)); }
        for (unsigned t = 256u; t < nmax; t += 32u) { const unsigned tt = t + (unsigned)j; const unsigned long long m = __builtin_amdgcn_ballot_w64(tt < n && lq[tt < n ? tt : 0u] >= cand);
            ca += (unsigned)__builtin_popcount((unsigned)m); cb += (unsigned)__builtin_popcount((unsigned)(m >> 32)); }
        const unsigned c = upper ? cb : ca;
        if (c >= R && cT != R) { T = cand; cT = c; }
    }
    unsigned mn = 0xffffffffu;
#pragma unroll
    for (int t = 0; t < 8; ++t) { const bool v = (unsigned)(j + 32 * t) < n && e[t] >= T; mn = v ? min(mn, e[t]) : mn; }
    for (unsigned t = 256u; t < nmax; t += 32u) { const unsigned tt = t + (unsigned)j; const unsigned x = lq[tt < n ? tt : 0u]; if (tt < n && x >= T) mn = min(mn, x); }
#pragma unroll
    for (int o = 1; o < 32; o <<= 1) mn = min(mn, bperm_u(lane ^ o, mn));
    if (j == 0 && n != 0u) qs[q * 4 + 2] = mn;
    __syncthreads();
}

template <int XM = 0> __device__ __forceinline__ void thr_unit(Frame& F, int b, int qt, const half_t* DQI, const half_t* DKI, const float* SMALL, unsigned* MASK) {
    LAS unsigned* hist = (LAS unsigned*)F.lds;
    LAS unsigned* stage = (LAS unsigned*)(F.lds + STAGE_OFF);
    LAS unsigned* qs = (LAS unsigned*)(F.lds + QS_OFF);
    LAS unsigned* flag = (LAS unsigned*)(F.lds + FLAG_OFF);
    LAS unsigned* cnt = (LAS unsigned*)(F.lds + CNT_OFF);
    const int tid = F.tid, lane = F.lane, w = F.wave, qc = lane & 15, kg = lane >> 4;
    const size_t rowb = (size_t)b * S;
    if (16 * qt + 15 < 256) {
        const int q = tid >> 5, j = tid & 31, nw = (qt >> 1) + 1, tq = 16 * qt + q;
        if (j < nw) { const int rem = tq - 32 * j; MASK[(rowb + tq) * 64 + j] = rem >= 31 ? 0xffffffffu : rem < 0 ? 0u : ((2u << rem) - 1u); }
        return;
    }
    const int tq = 16 * qt + qc;
    const size_t qrow = rowb + tq;
    unsigned key[16][4];
    {
        h8 qh[8]; float wt[8];
        h8 ka[16];
#pragma unroll
        for (int i = 0; i < 16; ++i) { const int kt = w + 8 * i, ktc = kt <= qt ? kt : qt; ka[i] = *(const h8*)(DKI + (rowb + 16 * ktc + qc) * 32 + 8 * kg); }
        { const unsigned zz_ = ou(0u); const u32x4 zv_ = {zz_, zz_, zz_, zz_};
#pragma unroll
          for (int i = 0; i < 8; ++i) *(LAS u32x4*)((LAS unsigned char*)hist + (size_t)(tid + 512 * i) * 16) = zv_;
          if (tid < 16) *(LAS u32x4*)((LAS unsigned char*)hist + (size_t)(4096 + tid) * 16) = zv_;
          if (tid < 256) *(LAS u32x4*)((LAS unsigned char*)stage + tid * 16) = zv_; }
#pragma unroll
        for (int h = 0; h < 8; ++h) qh[h] = *(const h8*)(DQI + qrow * 256 + 32 * h + 8 * kg);
        { const f32x4 a = *(const f32x4*)(SMALL + qrow * 16 + 8), c = *(const f32x4*)(SMALL + qrow * 16 + 12);
          wt[0] = a[0]; wt[1] = a[1]; wt[2] = a[2]; wt[3] = a[3]; wt[4] = c[0]; wt[5] = c[1]; wt[6] = c[2]; wt[7] = c[3]; }
        h8 qlin;
#pragma unroll
        for (int j = 0; j < 8; ++j) { float a = 0.f;
#pragma unroll
            for (int h = 0; h < 8; ++h) a = __builtin_fmaf(wt[h], (float)qh[h][j], a);
            qlin[j] = (half_t)a; }
        const float z0_ = zf(); const f32x4 z = {z0_, z0_, z0_, z0_};
#pragma unroll
        for (int i = 0; i < 16; ++i) {
            const int kt = w + 8 * i;
            if (kt <= qt) {
                f32x4 acc = XM == 3 ? z : __builtin_amdgcn_mfma_f32_16x16x32_f16(ka[i], qlin, z, 0, 0, 0);
#pragma unroll
                for (int h = 0; h < (XM == 3 ? 1 : 8); ++h) { const f32x4 sc = __builtin_amdgcn_mfma_f32_16x16x32_f16(ka[i], qh[h], z, 0, 0, 0);
#pragma unroll
                    for (int j = 0; j < 4; ++j) acc[j] = __builtin_fmaf(__builtin_fabsf(sc[j]), wt[h], acc[j]); }
#pragma unroll
                for (int j = 0; j < 4; ++j) key[i][j] = (16 * kt + 4 * kg + j <= tq) ? fkey(acc[j]) : 0u;
            } else {
#pragma unroll
                for (int j = 0; j < 4; ++j) key[i][j] = 0u;
            }
        }
    }
    if (tid < 16) { qs[tid * 4 + 0] = ou(0u); qs[tid * 4 + 1] = ou(1u); qs[tid * 4 + 2] = ou(0u); qs[tid * 4 + 3] = ou(0u); cnt[tid] = ou(0u); }
    __syncthreads();
    if (XM != 1) { thr_pass<0>(F, qt, key, hist, stage, qs, flag);
    if (XM != 2) thr_select(F, qt, key, hist, qs, cnt); }
    thr_pass<4>(F, qt, key, hist, stage, qs, flag);
    { const int q = tid >> 5, j = tid & 31, nw = (qt >> 1) + 1;
      unsigned* dst = MASK + (rowb + 16 * qt + q) * 64;
      if (j < nw) dst[j] = stage[q * 64 + j];
      if (j + 32 < nw) dst[j + 32] = stage[q * 64 + j + 32]; }
    __syncthreads();
}
}

#ifndef MK_FOX_SKIP
#define MK_FOX_SKIP 1
#endif
namespace att {
enum { FOX = 0, MLA = 1, DSA = 2, XA = 3 };
template <int KIND> struct Cfg {
    static constexpr int DQK = KIND == MLA ? 96 : KIND == XA ? 128 : 64, DV = KIND == XA ? 128 : 64;
    static constexpr int KSTR = DQK * 2 + 16, VSTR = DV == 64 ? 192 : 320;
    static constexpr int KT = 64, KB = KT * KSTR, VB = KT * VSTR;
    static constexpr int NKC = KT * DQK / 8, NVC = KT * DV / 8, NCH = NKC + NVC, NL = (NCH + 511) / 512;
    static constexpr bool CAUSAL = KIND != XA;
};
struct UD { const half_t* Q; int qp; const half_t* K0; int kp0; const half_t* K1; int kp1; const half_t* V; int vp; half_t* O; int op; const float* cum; const unsigned* mask; unsigned* mask_dbg; int dbg_shift; const unsigned char* base; const float* kn; };

typedef short v4i16_t __attribute__((ext_vector_type(4)));
__device__ __forceinline__ s16x4 vtr(const LAS unsigned char* p) { return __builtin_bit_cast(s16x4, __builtin_amdgcn_ds_read_tr16_b64_v4i16((LAS v4i16_t*)p)); }
__device__ __forceinline__ float max3(float a, float b, float c) { return fmaxf(fmaxf(a, b), c); }
__device__ __forceinline__ float sub_s(float a, float b) { float r; asm("v_sub_f32_e32 %0, %1, %2" : "=v"(r) : "v"(a), "v"(b)); return r; }
__device__ __forceinline__ float add_s(float a, float b) { float r; asm("v_add_f32_e32 %0, %1, %2" : "=v"(r) : "v"(a), "v"(b)); return r; }
__device__ __forceinline__ void mul_ip(float& x, float a) { asm volatile("v_mul_f32_e32 %0, %0, %1" : "+v"(x) : "v"(a)); }
__device__ __forceinline__ void sub_ip(float& x, float a) { asm volatile("v_sub_f32_e32 %0, %0, %1" : "+v"(x) : "v"(a)); }
__device__ __forceinline__ void set_ip(float& x, float a) { asm volatile("v_mov_b32_e32 %0, %1" : "+v"(x) : "v"(a)); }

template <int KIND, int EXP = 0>
__device__ __forceinline__ void attn_unit(Frame& F, const UD& ud, size_t rowk, size_t rowq, int qb) {
    typedef Cfg<KIND> C;
    constexpr bool REV = (KIND == FOX);
    int tid_ = F.tid, lane_ = F.lane; asm volatile("" : "+v"(tid_), "+v"(lane_));
    const int tid = tid_, lane = lane_, w = F.wave, qi = lane & 31, hh = lane >> 5;
    LAS unsigned char* lds = F.lds;
    const int NT = EXP == 5 ? 1 : (C::CAUSAL ? 4 * qb + 4 : 4);
    const int tlim = C::CAUSAL ? 4 * qb + (w >> 1) : 3;
    const unsigned char* sp[C::NL]; int sstep[C::NL]; int ldo[C::NL]; bool sv[C::NL];
#pragma unroll
    for (int i = 0; i < C::NL; ++i) {
        const int c = tid + 512 * i; sv[i] = (C::NCH % 512 == 0) ? true : (c < C::NCH);
        const int cc = sv[i] ? c : 0;
        if (cc < C::NKC) { const int row = cc / (C::DQK / 8), c8 = cc % (C::DQK / 8);
            if (KIND == MLA && c8 >= 8) { sp[i] = (const unsigned char*)(ud.K1 + (rowk + row) * ud.kp1 + 8 * (c8 - 8)); sstep[i] = C::KT * ud.kp1 * 2; }
            else { sp[i] = (const unsigned char*)(ud.K0 + (rowk + row) * ud.kp0 + 8 * c8); sstep[i] = C::KT * ud.kp0 * 2; }
            ldo[i] = row * C::KSTR + c8 * 16;
        } else { const int cv = cc - C::NKC, row = cv / (C::DV / 8), c8 = cv % (C::DV / 8);
            sp[i] = (const unsigned char*)(ud.V + (rowk + row) * ud.vp + 8 * c8); sstep[i] = C::KT * ud.vp * 2;
            ldo[i] = 2 * C::KB + row * C::VSTR + c8 * 16; }
    }
    u32x4 stg[C::NL];
#define ATT_LOAD(R, t) do { _Pragma("unroll") for (int i = 0; i < C::NL; ++i) R[i] = *(const GAS u32x4*)(sp[i] + (size_t)(EXP == 1 ? 0 : (t)) * sstep[i]); } while (0)
#define ATT_WRITE(R, p) do { _Pragma("unroll") for (int i = 0; i < C::NL; ++i) if (sv[i]) *(LAS u32x4*)(lds + ldo[i] + ((ldo[i] >= 2 * C::KB) ? (p) * C::VB : (p) * C::KB)) = R[i]; } while (0)
    f32x4 cbn[2][4];
    ATT_LOAD(stg, REV ? NT - 1 : 0);
    if (KIND == FOX) { const float* cp = ud.cum + 64 * (NT - 1) + 4 * (lane >> 5);
#pragma unroll
        for (int j = 0; j < 2; ++j)
#pragma unroll
            for (int g = 0; g < 4; ++g) cbn[j][g] = *(const f32x4*)(cp + 32 * j + 8 * g); }
    h8 qf[C::DQK / 16];
    { const half_t* qp = ud.Q + (rowq + 32 * w + qi) * ud.qp + 8 * hh;
#pragma unroll
      for (int ks = 0; ks < C::DQK / 16; ++ks) qf[ks] = *(const h8*)(qp + 16 * ks); }
    LAS float* xq = (LAS float*)(lds + RING_BYTES + 128);
    float kpre = 0.f;
    if (REV) {
        float qq = 0.f;
#pragma unroll
        for (int ks = 0; ks < C::DQK / 16; ++ks)
#pragma unroll
            for (int e = 0; e < 8; ++e) { const float x = (float)qf[ks][e]; qq = __builtin_fmaf(x, x, qq); }
        qq += bperm_f(lane ^ 32, qq);
#pragma unroll
        for (int o = 1; o < 32; o <<= 1) qq = fmaxf(qq, bperm_f(lane ^ o, qq));
        if (lane == 0) xq[w] = qq;
        kpre = ud.kn[lane & 31];
#pragma unroll
        for (int o = 1; o < 32; o <<= 1) { const float t_ = bperm_f((lane & 31) >= o ? lane - o : lane, kpre); kpre = fmaxf(kpre, t_); }
    }
    float cnx = 0.f;
    float qn_ub = 0.f, mmin_blk = 0.f;
    float mref = 0.f, l_run = 0.f; bool init = false;
    f32x16 negm;
#pragma unroll
    for (int r = 0; r < 16; ++r) negm[r] = zf();
    u32x2 mwn = {0xffffffffu, 0xffffffffu};
    if (KIND == DSA) mwn = *(const u32x2*)(ud.mask + (size_t)(256 * qb + 32 * w + qi) * 64);
    f32x16 o[C::DV / 32]; const float zo_ = zf();
#pragma unroll
    for (int d0 = 0; d0 < C::DV / 32; ++d0)
#pragma unroll
        for (int r = 0; r < 16; ++r) o[d0][r] = zo_;
    ATT_WRITE(stg, 0);
#pragma unroll
    for (int ks = 0; ks < C::DQK / 16; ++ks) asm volatile("" :: "v"(qf[ks]));
    __syncthreads();
    const int kroff = qi * C::KSTR + hh * 16;
    const int vroff = 2 * C::KB + (4 * hh + ((lane & 15) >> 2)) * C::VSTR + (16 * ((lane >> 4) & 1) + 4 * (lane & 3)) * 2;
    const int qrel = 32 * w + qi;
    for (int it = 0; it < NT; ++it) {
        const int t = REV ? NT - 1 - it : it, tn = REV ? t - 1 : t + 1;
        const int p = it & 1;
        if (REV && it >= 4) {
            if (it == 4) { float a = xq[0], b_ = xq[8];
#pragma unroll
                for (int i = 1; i < 8; ++i) { a = fmaxf(a, xq[i]); b_ = fminf(b_, xq[8 + i]); }
                qn_ub = sqrtf(a) * 1.0001f; mmin_blk = b_; }
            const float ub = qn_ub * __int_as_float(__builtin_amdgcn_readlane(__float_as_int(kpre), t)) + 0.001f - cnx;
            if (ub < mmin_blk - 40.0f) break;
        }
        ATT_LOAD(stg, it + 1 < NT ? tn : t);
        if (REV) cnx = ud.cum[64 * (tn > 0 ? tn : 0) + 63];
        bool wrote = false;
        if (t <= tlim) {
            unsigned mw[2] = {0xffffffffu, 0xffffffffu};
            if (KIND == DSA) { mw[0] = mwn.x >> (4 * hh); mw[1] = mwn.y >> (4 * hh);
                if (t + 1 < NT) mwn = *(const u32x2*)(ud.mask + (size_t)(256 * qb + qrel) * 64 + 2 * (t + 1)); }
            f32x16 sT[2];
            const LAS unsigned char* kb = lds + p * C::KB + kroff;
            { f32x16 c0 = negm, c1 = negm;
              if (KIND == FOX) {
#pragma unroll
                  for (int r = 0; r < 16; ++r) { c0[r] = negm[r] - cbn[0][r >> 2][r & 3]; c1[r] = negm[r] - cbn[1][r >> 2][r & 3]; } }
              if (KIND == DSA) {
#pragma unroll
                  for (int r = 0; r < 16; ++r) { const int cr = (r & 3) + 8 * (r >> 2);
                      const unsigned m0 = (unsigned)__builtin_amdgcn_sbfe((int)mw[0], cr, 1), m1 = (unsigned)__builtin_amdgcn_sbfe((int)mw[1], cr, 1);
                      c0[r] = __uint_as_float((__float_as_uint(negm[r]) & m0) | (0xff800000u & ~m0));
                      c1[r] = __uint_as_float((__float_as_uint(negm[r]) & m1) | (0xff800000u & ~m1)); } }
              h8 ka0 = *(const LAS h8*)(kb), ka1 = *(const LAS h8*)(kb + 32 * C::KSTR);
              h8 kb0 = *(const LAS h8*)(kb + 32), kb1 = *(const LAS h8*)(kb + 32 * C::KSTR + 32);
              __builtin_amdgcn_sched_barrier(0);
              sT[0] = __builtin_amdgcn_mfma_f32_32x32x16_f16(ka0, qf[0], c0, 0, 0, 0);
              sT[1] = __builtin_amdgcn_mfma_f32_32x32x16_f16(ka1, qf[0], c1, 0, 0, 0);
#pragma unroll
              for (int ks = 1; ks < C::DQK / 16; ++ks) {
                  ka0 = kb0; ka1 = kb1;
                  if (ks + 1 < C::DQK / 16) { kb0 = *(const LAS h8*)(kb + 32 * (ks + 1)); kb1 = *(const LAS h8*)(kb + 32 * C::KSTR + 32 * (ks + 1)); }
                  __builtin_amdgcn_sched_barrier(0);
                  sT[0] = __builtin_amdgcn_mfma_f32_32x32x16_f16(ka0, qf[ks], sT[0], 0, 0, 0);
                  sT[1] = __builtin_amdgcn_mfma_f32_32x32x16_f16(ka1, qf[ks], sT[1], 0, 0, 0);
              }
              __builtin_amdgcn_sched_barrier(0); }
            float ps0 = 0.f, ps1 = 0.f;
            if (EXP < 9) {
            if (C::CAUSAL && t == tlim) {
                const int dq = 32 * w + qi - 64 * (t - 4 * qb) - 4 * hh;
#pragma unroll
                for (int j = 0; j < 2; ++j)
#pragma unroll
                    for (int r = 0; r < 16; ++r) { const int cr = (r & 3) + 8 * (r >> 2) + 32 * j; if (cr > dq) sT[j][r] = -INFINITY; }
            }
            float mx = max3(sT[0][0], sT[0][1], sT[1][0]);
#pragma unroll
            for (int r = 1; r < 8; ++r) mx = max3(mx, sT[0][2 * r], sT[0][2 * r + 1]);
#pragma unroll
            for (int r = 0; r < 8; ++r) mx = max3(mx, sT[1][2 * r], sT[1][2 * r + 1]);
            { const auto sw = __builtin_amdgcn_permlane32_swap(__float_as_uint(mx), __float_as_uint(mx), false, false);
              mx = fmaxf(__uint_as_float(sw[0]), __uint_as_float(sw[1])); }
            { const bool need = init ? (mx > 8.0f) : (mx > -INFINITY);
              if (__builtin_amdgcn_ballot_w64(need) != 0ull) {
                const float grow = need ? mx : 0.f;
                const float alpha = (need && init) ? __builtin_amdgcn_exp2f(-grow) : 1.0f;
                l_run *= alpha; mref += grow; init = init || need;
                const float nm = -mref;
#pragma unroll
                for (int d0 = 0; d0 < C::DV / 32; ++d0)
#pragma unroll
                    for (int r = 0; r < 16; ++r) { float x = o[d0][r]; mul_ip(x, alpha); o[d0][r] = x; }
#pragma unroll
                for (int r = 0; r < 16; ++r) { float x0 = sT[0][r], x1 = sT[1][r], x2 = negm[r]; sub_ip(x0, grow); sub_ip(x1, grow); set_ip(x2, nm); sT[0][r] = x0; sT[1][r] = x1; negm[r] = x2; }
              } }
            if (REV && t == tlim) { float mm = mref;
#pragma unroll
                for (int o = 1; o < 64; o <<= 1) mm = fminf(mm, bperm_f(lane ^ o, mm));
                if (lane == 0) xq[8 + w] = mm; }
            if (!(REV && MK_FOX_SKIP && __builtin_amdgcn_ballot_w64(mx > -40.0f) == 0ull)) {
#pragma unroll
            for (int r = 0; r < 16; ++r) { sT[0][r] = __builtin_amdgcn_exp2f(sT[0][r]); ps0 += sT[0][r]; sT[1][r] = __builtin_amdgcn_exp2f(sT[1][r]); ps1 += sT[1][r]; }
            l_run += ps0 + ps1;
            h8 pf[4];
#pragma unroll
            for (int s = 0; s < 4; ++s) { const int j = s >> 1, b8 = 8 * (s & 1);
                u32x4 pw; pw.x = pkh(sT[j][b8], sT[j][b8 + 1]); pw.y = pkh(sT[j][b8 + 2], sT[j][b8 + 3]); pw.z = pkh(sT[j][b8 + 4], sT[j][b8 + 5]); pw.w = pkh(sT[j][b8 + 6], sT[j][b8 + 7]);
                pf[s] = __builtin_bit_cast(h8, pw); }
            if (it + 1 < NT) ATT_WRITE(stg, p ^ 1);
            wrote = true;
            const LAS unsigned char* vb = lds + p * C::VB + vroff;
            s16x4 va0 = vtr(vb), va1 = vtr(vb + 8 * C::VSTR);
#pragma unroll
            for (int i = 0; i < 4 * (C::DV / 32); ++i) { constexpr int ND = C::DV / 32; const int d0 = i % ND, s = i / ND;
                const s16x8 av = {va0[0], va0[1], va0[2], va0[3], va1[0], va1[1], va1[2], va1[3]};
                if (i + 1 < 4 * (C::DV / 32)) { const int d1 = (i + 1) % ND, s1 = (i + 1) / ND; va0 = vtr(vb + (16 * s1) * C::VSTR + 64 * d1); va1 = vtr(vb + (16 * s1 + 8) * C::VSTR + 64 * d1); }
                __builtin_amdgcn_sched_barrier(0);
                o[d0] = __builtin_amdgcn_mfma_f32_32x32x16_f16(__builtin_bit_cast(h8, av), pf[s], o[d0], 0, 0, 0);
            }
            __builtin_amdgcn_sched_barrier(0);
            }
            }
        }
        if (KIND == FOX) { const float* cp = ud.cum + 64 * (tn > 0 ? tn : 0) + 4 * hh;
#pragma unroll
            for (int j = 0; j < 2; ++j)
#pragma unroll
                for (int g = 0; g < 4; ++g) cbn[j][g] = *(const f32x4*)(cp + 32 * j + 8 * g); }
        if (!wrote && it + 1 < NT) ATT_WRITE(stg, p ^ 1);
        if (EXP != 3) __syncthreads();
    }
#pragma unroll
    for (int i = 0; i < C::NL; ++i) asm volatile("" :: "v"(stg[i]));
#undef ATT_LOAD
#undef ATT_WRITE
    const float lt = l_run + bperm_f(lane ^ 32, l_run);
    const float inv = 1.0f / lt;
    constexpr int ORS = C::DV * 2 + 16;
    LAS unsigned char* ob = lds + w * (32 * ORS);
#pragma unroll
    for (int d0 = 0; d0 < C::DV / 32; ++d0)
#pragma unroll
        for (int rg = 0; rg < 4; ++rg) {
            u32x2 wv; wv.x = pkh(o[d0][4 * rg] * inv, o[d0][4 * rg + 1] * inv); wv.y = pkh(o[d0][4 * rg + 2] * inv, o[d0][4 * rg + 3] * inv);
            *(LAS u32x2*)(ob + qi * ORS + (32 * d0 + 8 * rg + 4 * hh) * 2) = wv;
        }
    half_t* og = ud.O + (rowq + 32 * w) * ud.op;
#pragma unroll
    for (int ps = 0; ps < (32 * (C::DV / 8)) / 64; ++ps) {
        const int c = lane + 64 * ps, row = c / (C::DV / 8), c8 = c % (C::DV / 8);
        const u32x4 v = *(const LAS u32x4*)(ob + row * ORS + 16 * c8);
        *(u32x4*)(og + (size_t)row * ud.op + 8 * c8) = v;
    }
}
}

#ifndef MK_REP_G4
#define MK_REP_G4 1
#endif
#ifndef MK_REP_THR
#define MK_REP_THR 1
#endif
__device__ __forceinline__ int q_pop(Frame& F, gu32* head) {
    if (F.tid == 0) F.MISC[16] = __hip_atomic_fetch_add(head, 1u, RLX_AGENT);
    __syncthreads();
    const int u = (int)F.MISC[16];
    __syncthreads();
    return u;
}


#if defined(MK_CKSUM)
constexpr size_t WS_DBG = WS_END + (1u << 20);
__device__ __forceinline__ void cksum(Frame& F, unsigned char* ws, int stage, size_t off, size_t bytes) {
    const u32x4* p = (const u32x4*)(ws + off); const size_t n = bytes / 16;
    unsigned x = 0u;
    for (size_t i = (size_t)blockIdx.x * NTHREADS + F.tid; i < n; i += (size_t)gridDim.x * NTHREADS) { const u32x4 v = p[i]; x ^= v.x ^ (v.y * 3u) ^ (v.z * 5u) ^ (v.w * 7u); }
#pragma unroll
    for (int o = 1; o < 64; o <<= 1) x ^= bperm_u(F.lane ^ o, x);
    if (F.lane == 0) atomicXor((unsigned*)(ws + WS_CTL) + 2048 + stage, x);
}
#define CK(stage, off, bytes) do { PHASE_VARS cksum(F, ws, (stage), (off), (bytes)); } while (0)
#else
#define CK(stage, off, bytes) do { } while (0)
#endif
#define Q_FIRST(head) q_pop(F, (head))
#define Q_AHEAD(head, var) unsigned var = 0u; if (F.tid == 0) var = __hip_atomic_fetch_add((head), 1u, RLX_AGENT)
#define Q_NEXT(var, u) do { if (F.tid == 0) F.MISC[16] = var; __syncthreads(); u = (int)F.MISC[16]; __syncthreads(); } while (0)
__global__ void __launch_bounds__(NTHREADS, 2) mk_fwd(Args args) {
    extern __shared__ __attribute__((aligned(16))) unsigned char lds_raw[];
    Frame F;
    F.lds = (LAS unsigned char*)lds_raw;
    F.MISC = (volatile LAS unsigned*)(F.lds + MISC_OFF);
    F.tid = threadIdx.x; F.lane = F.tid & 63; F.wave = __builtin_amdgcn_readfirstlane(F.tid >> 6);
    const int wave_s = F.wave;
    F.G = gridDim.x; { const int bx = blockIdx.x; F.vcu = (F.G % 8 == 0) ? (bx % 8) * (F.G / 8) + bx / 8 : bx; }
    F.ws = nullptr; F.ctl = nullptr;
#if defined(MK_ZERO_LDS)
    for (int i = F.tid; i < LDS_BYTES / 16; i += NTHREADS) *(LAS u32x4*)(F.lds + (size_t)i * 16) = (u32x4){0u, 0u, 0u, 0u};
    __syncthreads();
#endif
    if (F.tid < 32) F.MISC[F.tid] = 0u;
    __syncthreads();
#if defined(MK_SYS_ACQ)
    if (F.tid == 0) { __builtin_amdgcn_fence(__ATOMIC_ACQUIRE, ""); asm volatile("s_waitcnt vmcnt(0)" ::: "memory"); }
    __syncthreads();
#endif
    XcdBarrier bar = xcd_barrier_post((unsigned*)(kargs()->ws + WS_CTL) + CW_BAR, F.MISC + 8);
#define GRID_BAR() do { bar.bar = (unsigned*)(kargs()->ws + WS_CTL) + CW_BAR; { unsigned x_ = bar.x; asm volatile("" : "+s"(x_)); bar.x = x_; } xcd_barrier(bar); } while (0)
#define PHASE_VARS CArgs* ka = kargs(); unsigned char* ws = ka->ws; int bx_ = (int)blockIdx.x, G_ = (int)gridDim.x; asm volatile("" : "+s"(bx_), "+s"(G_)); const int bx = bx_, G = G_; (void)bx; (void)G; (void)ws; \
    { int ln_; asm volatile("v_mbcnt_lo_u32_b32 %0, -1, 0\n\tv_mbcnt_hi_u32_b32 %0, -1, %0" : "=v"(ln_)); int wv_ = wave_s; asm volatile("" : "+s"(wv_)); F.lane = ln_; F.wave = wv_; F.tid = wv_ * 64 + ln_; }
    (void)args;

    { PHASE_VARS F.ws = ws; p0_prologue(F, ka); F.ws = nullptr; }
    GRID_BAR();
#if defined(MK_L2TEST)
    { PHASE_VARS
      unsigned* X = (unsigned*)(ws + WS_END2 + (1u << 20)); unsigned* flagw = (unsigned*)(ws + WS_CTL) + 1024;
      const int NW = 16384;
      if (bx == 3) for (int i = F.tid; i < NW; i += NTHREADS) X[i] = 0xA0000000u + (unsigned)i;
      GRID_BAR();
      { unsigned acc = 0u; for (int i = F.tid; i < NW; i += NTHREADS) acc += X[i] - (0xA0000000u + (unsigned)i); if (acc != 0u) atomicOr(flagw, 1u); }
      GRID_BAR();
      if (bx == 5) for (int i = F.tid; i < NW; i += NTHREADS) X[i] = 0xB0000000u + (unsigned)i;
      GRID_BAR();
      { unsigned bad = 0u; for (int i = F.tid; i < NW; i += NTHREADS) {
#if MK_L2TEST == 2
            const unsigned v = __hip_atomic_load(X + i, __ATOMIC_RELAXED, __HIP_MEMORY_SCOPE_AGENT);
#else
            const unsigned v = X[i];
#endif
            bad |= (v != 0xB0000000u + (unsigned)i) ? 1u : 0u; }
        if (bad) atomicOr(flagw, 2u); }
      GRID_BAR(); }
#endif
#if defined(MK_EXP_PRO)
    { PHASE_VARS F.ws = ws; p0_prologue<MK_EXP_PRO>(F, ka); F.ws = nullptr; }
    GRID_BAR();
#endif

    CK(1, WS_XN, (size_t)M * D * 2 + (size_t)M * 64); CK(3, WS_W, 2 * WL_STRIDE + TAB_BYTES);
#pragma unroll 1
    for (int l = 0; l < 2; ++l) {
        { PHASE_VARS
          pg8::Gemm g{(const half_t*)(ws + WS_XN), wl_ptr(ws, l, WL_WI1), M, 2 * DFF, D}; pg8::StaticOrder So; So.init(M, 2 * DFF, G, bx);
          epi::prep_srow(F.lds, (const float*)(ws + WS_SS), So, F.tid);
          epi::EpiUp E{ws, F.lds};
          pg8::gemm_phase<epi::EpiUp, pg8::StaticOrder, true, true>(F.lds, g, So, E, F.tid); }
        GRID_BAR();
        { PHASE_VARS
          pg8::Gemm g{(const half_t*)(ws + WS_HID), wl_ptr(ws, l, WL_WO1), M, D, DFF}; pg8::StaticOrder So; So.init(M, D, G, bx);
          epi::EpiRes E{ws, 0.5f};
          pg8::gemm_phase<epi::EpiRes, pg8::StaticOrder, true, true>(F.lds, g, So, E, F.tid); }
        GRID_BAR();
        CK(7 + 16 * l, WS_XN, (size_t)M * D * 2);
        { PHASE_VARS
          pg8::Gemm g{(const half_t*)(ws + WS_XN), wl_ptr(ws, l, WL_WIN), M, NWIN, D}; pg8::StaticOrder So; So.init(M, NWIN, G, bx);
          epi::prep_srow(F.lds, (const float*)(ws + WS_SS), So, F.tid);
          epi::EpiWin E{ws, F.lds};
          pg8::gemm_phase<epi::EpiWin, pg8::StaticOrder, true, true>(F.lds, g, So, E, F.tid); }
        { PHASE_VARS
          pg8::Gemm g{(const half_t*)(ws + WS_MEMB), wl_ptr(ws, l, WL_XWKV), MM, D, D}; pg8::StaticOrder So; So.init(MM, D, G, (bx + G / 4) % G);
          epi::EpiScale<1> E{ws, F.lds, WS_MEMKV, WS_MEMSS, D, 1.0f / 1024.0f, 1.0f};
          pg8::gemm_phase<epi::EpiScale<1>, pg8::StaticOrder, true, true>(F.lds, g, So, E, F.tid); }
        GRID_BAR();
        CK(9 + 16 * l, WS_QF, WS_CUM - WS_QF);
        for (int rep4 = 0; rep4 < MK_REP_G4; ++rep4) {
        { PHASE_VARS
          const int gw = F.vcu * NWAVES + F.wave;
          for (int tile = gw; tile < NB * 6 * 32; tile += G * NWAVES) { const int bh = tile >> 5, tt = tile & 31, b_ = bh / 6, h_ = bh - 6 * b_;
              const half_t* kr = (const half_t*)(ws + WS_KF) + ((size_t)b_ * S + 64 * tt + F.lane) * 384 + 64 * h_;
              float ss = 0.f;
#pragma unroll
              for (int c = 0; c < 8; ++c) { const h8 v = *(const h8*)(kr + 8 * c);
#pragma unroll
                  for (int e = 0; e < 8; ++e) { const float x = (float)v[e]; ss = __builtin_fmaf(x, x, ss); } }
#pragma unroll
              for (int o = 1; o < 64; o <<= 1) ss = fmaxf(ss, bperm_f(F.lane ^ o, ss));
              if (F.lane == 0) ((float*)(ws + WS_KN))[tile] = sqrtf(ss) * 1.0001f; }
          if (gw < NB * 6) scan_seq((const float*)(ws + WS_SMALL), ka->in[I_BF] + l * 6, (float*)(ws + (l ? WS_CUM2 : WS_CUM)), gw, F.lane);
          __syncthreads(); }
        { PHASE_VARS
          pg8::Gemm g{(const half_t*)(ws + WS_MCQ), wl_ptr(ws, l, WL_WUQ), M, 768, 256}; pg8::StaticOrder So; So.init(M, 768, G, bx);
          epi::EpiUq E{ws};
          pg8::gemm_phase<epi::EpiUq, pg8::StaticOrder, true, true>(F.lds, g, So, E, F.tid); }
        { PHASE_VARS
          pg8::Gemm g{(const half_t*)(ws + WS_MCKV), wl_ptr(ws, l, WL_WUKV), M, 768, 128}; pg8::StaticOrder So; So.init(M, 768, G, (bx + G / 2) % G);
          epi::EpiScale<4> E{ws, F.lds, WS_KVUP, WS_SSKV, 768, 1.0f / 128.0f, 1.0f};
          pg8::gemm_phase<epi::EpiScale<4>, pg8::StaticOrder, true, true>(F.lds, g, So, E, F.tid); }
        }
        for (int rep4 = 0; rep4 < MK_REP_THR; ++rep4) {
        { PHASE_VARS
          gu32* head = (gu32*)(ws + WS_CTL) + CW_QUEUE + 64 * (l * 4 + 0 + 16 * rep4);
          for (int u = Q_FIRST(head); u < NB * 128;) { Q_AHEAD(head, nxt_);
              const int qt = 127 - (u >> 4), b = u & 15;
#if defined(MK_EXP_THR)
              if (rep4 == 1) dsa::thr_unit<MK_EXP_THR>(F, b, qt, (const half_t*)(ws + WS_DQI), (const half_t*)(ws + WS_DKI), (const float*)(ws + WS_SMALL), (unsigned*)(ws + WS_END) - (size_t)b * S * 64 - (size_t)16 * qt * 64); else
#endif
              dsa::thr_unit(F, b, qt, (const half_t*)(ws + WS_DQI), (const half_t*)(ws + WS_DKI), (const float*)(ws + WS_SMALL), (unsigned*)(ws + WS_MASK));
              Q_NEXT(nxt_, u); } }
        }
        GRID_BAR();
        CK(10 + 16 * l, WS_CUM, WS_MASK - WS_CUM); CK(11 + 16 * l, WS_MASK, (size_t)M * 256);
        { PHASE_VARS
          gu32* head = (gu32*)(ws + WS_CTL) + CW_QUEUE + 64 * (l * 4 + 1);
          half_t* MIX = (half_t*)(ws + WS_MIX);
          for (int u = Q_FIRST(head); u < 2048;) { Q_AHEAD(head, nxt_);
              const int qb = u < 1280 ? 7 - u / 160 : 7 - (u - 1280) / 96, j = u < 1280 ? (u % 160 < 96 ? u % 160 : u % 160 + 96) : 96 + (u - 1280) % 96;
              att::UD ud{}; ud.base = ws;
              if (j < 96) { const int b = j / 6, h = j - 6 * b; const half_t* kv = (const half_t*)(ws + WS_KVUP) + 128 * h;
                  ud.Q = (const half_t*)(ws + WS_QUP) + 96 * h; ud.qp = 576; ud.K0 = kv; ud.kp0 = 768; ud.K1 = (const half_t*)(ws + WS_KR); ud.kp1 = 32; ud.V = kv + 64; ud.vp = 768;
                  ud.O = MIX + 384 + 64 * h; ud.op = D; ud.cum = nullptr; ud.mask = nullptr;
                  att::attn_unit<att::MLA>(F, ud, (size_t)b * S, (size_t)b * S + 256 * qb, qb);
              } else if (j < 192) { const int jj = j - 96, b = jj / 6, h = jj - 6 * b;
                  ud.Q = (const half_t*)(ws + WS_QF) + 64 * h; ud.qp = 384; ud.K0 = (const half_t*)(ws + WS_KF) + 64 * h; ud.kp0 = 384; ud.K1 = ud.K0; ud.kp1 = 384; ud.V = (const half_t*)(ws + WS_VF) + 64 * h; ud.vp = 384;
                  ud.O = MIX + 64 * h; ud.op = D; ud.cum = (const float*)(ws + (l ? WS_CUM2 : WS_CUM)) + (size_t)(b * 6 + h) * S; ud.mask = nullptr; ud.kn = (const float*)(ws + WS_KN) + (size_t)(b * 6 + h) * 32;
                  att::attn_unit<att::FOX>(F, ud, (size_t)b * S, (size_t)b * S + 256 * qb, qb);
              } else { const int jj = j - 192, b = jj >> 2, h = jj & 3;
                  ud.Q = (const half_t*)(ws + WS_DQ) + 64 * h; ud.qp = 256; ud.K0 = (const half_t*)(ws + WS_DK); ud.kp0 = 64; ud.K1 = ud.K0; ud.kp1 = 64; ud.V = (const half_t*)(ws + WS_DV); ud.vp = 64;
                  ud.O = MIX + 768 + 64 * h; ud.op = D; ud.cum = nullptr; ud.mask = (const unsigned*)(ws + WS_MASK) + (size_t)b * S * 64;
                  att::attn_unit<att::DSA>(F, ud, (size_t)b * S, (size_t)b * S + 256 * qb, qb);
              }
              Q_NEXT(nxt_, u); } }
        GRID_BAR();
        CK(13 + 16 * l, WS_MIX, (size_t)M * D * 2);
        { PHASE_VARS
          pg8::Gemm g{(const half_t*)(ws + WS_MIX), wl_ptr(ws, l, WL_WOUT), M, D, D}; pg8::StaticOrder So; So.init(M, D, G, bx);
          epi::EpiRes E{ws, 1.0f};
          pg8::gemm_phase<epi::EpiRes, pg8::StaticOrder, true, true>(F.lds, g, So, E, F.tid); }
        GRID_BAR();
        { PHASE_VARS
          pg8::Gemm g{(const half_t*)(ws + WS_XN), wl_ptr(ws, l, WL_XWQ), M, 512, D}; pg8::StaticOrder So; So.init(M, 512, G, bx);
          epi::prep_srow(F.lds, (const float*)(ws + WS_SS), So, F.tid);
          epi::EpiScale<16> E{ws, F.lds, WS_QX, WS_SS, 512, 1.0f / 1024.0f, 0.08838834764831845f * LOG2E};
          pg8::gemm_phase<epi::EpiScale<16>, pg8::StaticOrder, true, true>(F.lds, g, So, E, F.tid); }
        GRID_BAR();
        { PHASE_VARS
          for (int u = bx; u < NB * 4 * 8; u += G) {
            const int qb = u & 7, bh = u >> 3, b = bh >> 2, h = bh & 3;
            att::UD ud{}; ud.base = ws; const half_t* kv = (const half_t*)(ws + WS_MEMKV) + 128 * h;
            ud.Q = (const half_t*)(ws + WS_QX) + 128 * h; ud.qp = 512; ud.K0 = kv; ud.kp0 = D; ud.K1 = kv; ud.kp1 = D; ud.V = kv + 512; ud.vp = D;
            ud.O = (half_t*)(ws + WS_OX) + 128 * h; ud.op = 512; ud.cum = nullptr; ud.mask = nullptr;
            att::attn_unit<att::XA>(F, ud, (size_t)b * MEM, (size_t)b * S + 256 * qb, qb);
            __syncthreads();
          } }
        GRID_BAR();
        { PHASE_VARS
          pg8::Gemm g{(const half_t*)(ws + WS_OX), wl_ptr(ws, l, WL_XWO), M, D, 512}; pg8::StaticOrder So; So.init(M, D, G, bx);
          epi::EpiRes E{ws, 1.0f};
          pg8::gemm_phase<epi::EpiRes, pg8::StaticOrder, true, true>(F.lds, g, So, E, F.tid); }
        GRID_BAR();
        CK(17 + 16 * l, WS_XN, (size_t)M * D * 2);
        { PHASE_VARS
          pg8::Gemm g{(const half_t*)(ws + WS_XN), wl_ptr(ws, l, WL_WI2), M, 2 * DFF, D}; pg8::StaticOrder So; So.init(M, 2 * DFF, G, bx);
          epi::prep_srow(F.lds, (const float*)(ws + WS_SS), So, F.tid);
          epi::EpiUp E{ws, F.lds};
          pg8::gemm_phase<epi::EpiUp, pg8::StaticOrder, true, true>(F.lds, g, So, E, F.tid); }
        GRID_BAR();
        { PHASE_VARS
          pg8::Gemm g{(const half_t*)(ws + WS_HID), wl_ptr(ws, l, WL_WO2), M, D, DFF}; pg8::StaticOrder So; So.init(M, D, G, bx);
          epi::EpiRes E{ws, 0.5f};
          pg8::gemm_phase<epi::EpiRes, pg8::StaticOrder, true, true>(F.lds, g, So, E, F.tid); }
        GRID_BAR();
    }
#if defined(MK_CKSUM)
    CK(40, WS_XN, (size_t)M * D * 2);
    GRID_BAR();
    { PHASE_VARS
      unsigned* cur = (unsigned*)(ws + WS_CTL) + 2048; unsigned* pst = (unsigned*)(ws + WS_DBG);
      if (blockIdx.x == 0 && F.tid == 0) {
          const bool have = pst[0] == 0x5eedc0deu && pst[1] == 0x0badf00du;
          unsigned first = 0u;
          if (have) for (int s = 1; s <= 40; ++s) if (first == 0u && __hip_atomic_load(cur + s, RLX_AGENT) != pst[64 + s]) first = (unsigned)s;
          for (int s = 1; s <= 40; ++s) pst[64 + s] = __hip_atomic_load(cur + s, RLX_AGENT);
          if (!have) { pst[0] = 0x5eedc0deu; pst[1] = 0x0badf00du; pst[2] = 0u; }
          else if (pst[2] == 0u && first != 0u) pst[2] = first;
      } }
#endif
    { PHASE_VARS
      const float* gn = ka->in[I_FINN]; float* out = ka->out; const float* SS = (const float*)(ws + WS_SS); const half_t* XN = (const half_t*)(ws + WS_XN);
      const int gw = F.vcu * NWAVES + F.wave, NGW = G * NWAVES;
      f32x4 gv[4];
#pragma unroll
      for (int j = 0; j < 4; ++j) gv[j] = *((const GAS f32x4*)gn + F.lane + 64 * j);
      for (int m0 = gw; m0 < M; m0 += 2 * NGW) {
          u32x2 xv[2][4]; float sc[2];
#pragma unroll
          for (int u = 0; u < 2; ++u) { const int m = m0 + u * NGW; if (m < M) { const GAS u32x2* xr = (const GAS u32x2*)(XN + (size_t)m * D) + F.lane;
#pragma unroll
              for (int j = 0; j < 4; ++j) xv[u][j] = xr[64 * j];
              sc[u] = epi::rs_from(epi::row_ss<16>(SS, m), 1.0f / 1024.0f); } }
#pragma unroll
          for (int u = 0; u < 2; ++u) { const int m = m0 + u * NGW; if (m < M) { GAS f32x4* orow = (GAS f32x4*)(out + (size_t)m * D) + F.lane; const float s = sc[u];
#pragma unroll
              for (int j = 0; j < 4; ++j) { const h4 v = __builtin_bit_cast(h4, xv[u][j]);
                  f32x4 o = {(float)v[0] * s * gv[j][0], (float)v[1] * s * gv[j][1], (float)v[2] * s * gv[j][2], (float)v[3] * s * gv[j][3]}; orow[64 * j] = o; } } }
      } }
}

extern "C" void kernel_launch(void* const* d_in, const int* in_sizes, int n_in, void* d_out, int out_size, void* d_ws, size_t ws_size, hipStream_t stream) {
    static int grid = 0;
    if (grid == 0) {
        if (n_in != 22 || in_sizes[0] != M * D || out_size != M * D || ws_size < WS_END2) {
            fprintf(stderr, "kernel_launch: unexpected shapes: n_in %d in0 %d out %d ws %zu (need %zu)\n", n_in, n_in > 0 ? in_sizes[0] : -1, out_size, ws_size, (size_t)WS_END); grid = -1; return; }
        int dev = 0, cus = 0, per_cu = 0;
        if (hipGetDevice(&dev) != hipSuccess || hipDeviceGetAttribute(&cus, hipDeviceAttributeMultiprocessorCount, dev) != hipSuccess) { grid = -1; return; }
        if (hipFuncSetAttribute((const void*)mk_fwd, hipFuncAttributeMaxDynamicSharedMemorySize, LDS_BYTES) != hipSuccess) { fprintf(stderr, "kernel_launch: hipFuncSetAttribute failed\n"); grid = -1; return; }
        if (hipOccupancyMaxActiveBlocksPerMultiprocessor(&per_cu, (const void*)mk_fwd, NTHREADS, LDS_BYTES) != hipSuccess || per_cu < 1)
            fprintf(stderr, "kernel_launch: occupancy query reports %d workgroups per CU\n", per_cu);
        (void)hipGetLastError();
        grid = cus;
    }
    if (grid < 0) return;
    if (hipMemsetAsync((char*)d_ws + WS_CTL, 0, CTL_ZERO_BYTES, stream) != hipSuccess) return;
    Args a{};
    for (int i = 0; i < 22; ++i) a.in[i] = (const float*)d_in[i];
    a.out = (float*)d_out; a.ws = (unsigned char*)d_ws;
    hipLaunchKernelGGL(mk_fwd, dim3(grid), dim3(NTHREADS), LDS_BYTES, stream, a);
}
```

```cpp
#include <hip/hip_runtime.h>
#include <cstdio>
#include <cstdint>
#include <math.h>

#define GAS __attribute__((address_space(1)))
#define LAS __attribute__((address_space(3)))
typedef _Float16 half_t;
typedef _Float16 h8 __attribute__((ext_vector_type(8)));
typedef _Float16 h4 __attribute__((ext_vector_type(4)));
typedef _Float16 h2 __attribute__((ext_vector_type(2)));
typedef short s16x8 __attribute__((ext_vector_type(8)));
typedef short s16x4 __attribute__((ext_vector_type(4)));
typedef float f32x2 __attribute__((ext_vector_type(2)));
typedef float f32x4 __attribute__((ext_vector_type(4)));
typedef float f32x16 __attribute__((ext_vector_type(16)));
typedef unsigned u32x2 __attribute__((ext_vector_type(2)));
typedef unsigned u32x4 __attribute__((ext_vector_type(4)));
typedef GAS unsigned gu32;

constexpr int D = 1024, S = 2048, NB = 16, M = NB * S, DFF = 2816, DIN = 2254, MEM = 256, MM = NB * MEM;
constexpr int NWIN = 2304;
constexpr int C_FQ = 0, C_FK = 384, C_FV = 768, C_FF = 1152, C_MCQ = 1158, C_MCKV = 1414, C_MKR = 1542,
              C_DQ = 1574, C_DK = 1830, C_DV = 1894, C_DQI = 1958, C_DKI = 2214, C_DWI = 2246;
constexpr float EPS = 1e-6f, LOG2E = 1.4426950408889634f;

constexpr size_t MiB = 1u << 20;
constexpr size_t WS_CTL = 0, CTL_ZERO_BYTES = 1 * MiB;
constexpr size_t WL_WI1 = 0;
constexpr size_t WL_WO1 = WL_WI1 + (size_t)5632 * 1024 * 2;
constexpr size_t WL_WIN = WL_WO1 + (size_t)1024 * 2816 * 2;
constexpr size_t WL_WUQ = WL_WIN + (size_t)NWIN * 1024 * 2;
constexpr size_t WL_WUKV = WL_WUQ + (size_t)768 * 256 * 2;
constexpr size_t WL_WOUT = WL_WUKV + (size_t)768 * 128 * 2;
constexpr size_t WL_XWQ = WL_WOUT + (size_t)1024 * 1024 * 2;
constexpr size_t WL_XWKV = WL_XWQ + (size_t)512 * 1024 * 2;
constexpr size_t WL_XWO = WL_XWKV + (size_t)1024 * 1024 * 2;
constexpr size_t WL_WI2 = WL_XWO + (size_t)1024 * 512 * 2;
constexpr size_t WL_WO2 = WL_WI2 + (size_t)5632 * 1024 * 2;
constexpr size_t WL_BYTES = WL_WO2 + (size_t)1024 * 2816 * 2;
constexpr size_t WL_STRIDE = (WL_BYTES + 4095) & ~(size_t)4095;
constexpr size_t WS_W = 1 * MiB;
constexpr size_t WS_TAB = WS_W + 2 * WL_STRIDE;
constexpr size_t TAB_BYTES = (size_t)2048 * (16 + 16 + 32 + 32) * 4;
constexpr size_t WS_XN = (WS_TAB + TAB_BYTES + 4095) & ~(size_t)4095;
constexpr size_t WS_SS = WS_XN + (size_t)M * D * 2;
constexpr size_t WS_MEMB = WS_SS + (size_t)M * 16 * 4;
constexpr size_t WS_MEMSS = WS_MEMB + (size_t)MM * D * 2;
constexpr size_t WS_MEMKV = WS_MEMSS + (size_t)MM * 4;
constexpr size_t WS_BIG = (WS_MEMKV + (size_t)MM * D * 2 + 4095) & ~(size_t)4095;
constexpr size_t WS_HID = WS_BIG;
constexpr size_t WS_QF = WS_BIG;
constexpr size_t WS_KF = WS_QF + (size_t)M * 384 * 2;
constexpr size_t WS_VF = WS_KF + (size_t)M * 384 * 2;
constexpr size_t WS_MCQ = WS_VF + (size_t)M * 384 * 2;
constexpr size_t WS_MCKV = WS_MCQ + (size_t)M * 256 * 2;
constexpr size_t WS_DQ = WS_MCKV + (size_t)M * 128 * 2;
constexpr size_t WS_DK = WS_DQ + (size_t)M * 256 * 2;
constexpr size_t WS_DV = WS_DK + (size_t)M * 64 * 2;
constexpr size_t WS_DQI = WS_DV + (size_t)M * 64 * 2;
constexpr size_t WS_DKI = WS_DQI + (size_t)M * 256 * 2;
constexpr size_t WS_KR = WS_DKI + (size_t)M * 32 * 2;
constexpr size_t WS_SMALL = WS_KR + (size_t)M * 32 * 2;
constexpr size_t WS_CUM = WS_SMALL + (size_t)M * 16 * 4;
constexpr size_t WS_SSQ = WS_CUM + (size_t)NB * 6 * S * 4;
constexpr size_t WS_SSKV = WS_SSQ + (size_t)M * 4 * 4;
constexpr size_t WS_QUP = WS_SSKV + (size_t)M * 4 * 4;
constexpr size_t WS_KVUP = WS_QUP + (size_t)M * 576 * 2;
constexpr size_t WS_MASK = WS_KVUP + (size_t)M * 768 * 2;
constexpr size_t WS_MIX = WS_MASK + (size_t)M * 64 * 4;
constexpr size_t WS_QX = WS_QF;
constexpr size_t WS_OX = WS_QX + (size_t)M * 512 * 2;
constexpr size_t WS_END = WS_MIX + (size_t)M * D * 2;
static_assert(WS_OX + (size_t)M * 512 * 2 <= WS_MCQ, "QX/OX overlay QF/KF/VF");
static_assert(WS_HID + (size_t)M * DFF * 2 <= WS_END, "HID inside BIG");
constexpr size_t WS_CUM2 = WS_END;
constexpr size_t WS_KN = WS_CUM2 + (size_t)NB * 6 * S * 4;
constexpr size_t WS_END2 = WS_KN + (size_t)NB * 6 * 32 * 4;
static_assert(WS_END2 + (2u << 20) <= 512 * MiB, "workspace budget");

constexpr int CW_BAR = 4096;
constexpr int CW_QUEUE = 8192;

constexpr int RING_BYTES = 131072;
constexpr int MISC_OFF = RING_BYTES;
constexpr int LDS_BYTES = 147456;
constexpr int NWAVES = 8, NTHREADS = 512;

#define LDS_WAIT() asm volatile("s_waitcnt lgkmcnt(0)" ::: "memory")
#define VM_WAIT() asm volatile("s_waitcnt vmcnt(0)" ::: "memory")
#define RLX_AGENT __ATOMIC_RELAXED, __HIP_MEMORY_SCOPE_AGENT

__device__ __forceinline__ unsigned pkh(float lo, float hi) { f32x2 v = {lo, hi}; h2 h = __builtin_convertvector(v, h2); return __builtin_bit_cast(unsigned, h); }
__device__ __forceinline__ float wave_sum(float v) {
#pragma unroll
    for (int o = 1; o < 64; o <<= 1) v += __shfl_xor(v, o);
    return v;
}
__device__ __forceinline__ float zf() { float z = 0.f; asm volatile("" : "+v"(z)); return z; }
__device__ __forceinline__ unsigned ou(unsigned x) { asm volatile("" : "+v"(x)); return x; }
__device__ __forceinline__ float bperm_f(int srclane, float v) { return __int_as_float(__builtin_amdgcn_ds_bpermute(srclane << 2, __float_as_int(v))); }
__device__ __forceinline__ unsigned bperm_u(int srclane, unsigned v) { return (unsigned)__builtin_amdgcn_ds_bpermute(srclane << 2, (int)v); }
__host__ __device__ __forceinline__ int perm32(int rho) { const int n = rho >> 4, i = rho & 15; return 8 * (i >> 2) + 4 * n + (i & 3); }

#define XB_TMO      128
#define XB_XCNT(j)  (256  + 64 * (j))
#define XB_XSUB(j)  (1280 + 64 * (j))
#define XB_XGEN(j)  (2304 + 64 * (j))
#define XB_TOP      3328
#define XB_TOPGEN   3392
#define XCD_BAR_WORDS 3456
#define XB_SPIN_CAP (1u << 18)

__device__ __forceinline__ unsigned xb_ld(unsigned* p)              { return __hip_atomic_load(p, __ATOMIC_RELAXED, __HIP_MEMORY_SCOPE_AGENT); }
__device__ __forceinline__ unsigned xb_add(unsigned* p, unsigned v) { return __hip_atomic_fetch_add(p, v, __ATOMIC_RELAXED, __HIP_MEMORY_SCOPE_AGENT); }
__device__ __forceinline__ unsigned xb_xcc_id() { return (unsigned)__builtin_amdgcn_s_getreg((3 << 11) | 20) & 0xFu; }
#define XB_SPIN(cond, bar) do { unsigned _sp = 0; while (cond) { __builtin_amdgcn_s_sleep(1); \
    if ((++_sp & 255u) == 0u) { if (xb_ld(&(bar)[XB_TMO])) break; if (_sp > XB_SPIN_CAP) { atomicAdd(&(bar)[XB_TMO], 1u); break; } } } } while (0)

struct XcdBarrier {
    unsigned* bar; unsigned x;
    volatile LAS unsigned* st;
};

__device__ __forceinline__ XcdBarrier xcd_barrier_post(unsigned* bar, volatile LAS unsigned* st) {
    XcdBarrier b; b.bar = bar; b.x = xb_xcc_id(); b.st = st;
    if (threadIdx.x == 0) (void)xb_add(&bar[XB_XCNT(b.x)], 1u);
    return b;
}
__device__ __forceinline__ void xcd_barrier_complete(unsigned* bar, unsigned x, unsigned& nloc, unsigned& nx) {
    const unsigned G = gridDim.x * gridDim.y * gridDim.z;
    unsigned sum, cnt, mine, sp = 0u;
    for (;;) {
        sum = 0u; cnt = 0u; mine = 0u;
#pragma unroll
        for (unsigned j = 0; j < 16; ++j) { const unsigned c = xb_ld(&bar[XB_XCNT(j)]); sum += c; cnt += (c > 0u) ? 1u : 0u; mine = (j == x) ? c : mine; }
        if (sum == G) break;
        __builtin_amdgcn_s_sleep(1);
        if ((++sp & 255u) == 0u) { if (xb_ld(&bar[XB_TMO])) break; if (sp > XB_SPIN_CAP) { atomicAdd(&bar[XB_TMO], 1u); break; } }
    }
    nloc = mine > 0u ? mine : 1u; nx = cnt > 0u ? cnt : 1u;
}

__device__ __forceinline__ void xcd_barrier(const XcdBarrier& b) {
    asm volatile("s_waitcnt vmcnt(0)" ::: "memory");
    __syncthreads();
    if (threadIdx.x == 0) {
        unsigned* bar = b.bar;
        __builtin_amdgcn_s_waitcnt(0);
        unsigned nloc = b.st[0], nx = b.st[1];
        if (nloc == 0u) { xcd_barrier_complete(bar, b.x, nloc, nx); b.st[0] = nloc; b.st[1] = nx; }
        const unsigned old = xb_add(&bar[XB_XSUB(b.x)], 1u);
        const unsigned gen = old / nloc;
        if (old + 1u == (gen + 1u) * nloc) {
            __builtin_amdgcn_fence(__ATOMIC_RELEASE, "agent");
            asm volatile("s_waitcnt vmcnt(0)" ::: "memory");
            const unsigned og = xb_add(&bar[XB_TOP], 1u);
            const unsigned tg = og / nx;
            if (og + 1u == (tg + 1u) * nx) xb_add(&bar[XB_TOPGEN], 1u);
            else XB_SPIN(xb_ld(&bar[XB_TOPGEN]) == tg, bar);
            __builtin_amdgcn_fence(__ATOMIC_ACQUIRE, "agent");
            xb_add(&bar[XB_XGEN(b.x)], 1u);
            asm volatile("s_waitcnt vmcnt(0)" ::: "memory");
        } else {
            XB_SPIN(xb_ld(&bar[XB_XGEN(b.x)]) == gen, bar);
            __builtin_amdgcn_fence(__ATOMIC_ACQUIRE, "agent");
            asm volatile("s_waitcnt vmcnt(0)" ::: "memory");
        }
    }
    __syncthreads();
}

namespace pg8 {
#define PG8_LAS __attribute__((address_space(3)))
constexpr int BM = 256, BK = 64, HALF = 128, HTB = HALF * BK * 2  , STAGE_BYTES = 8 * HTB, NXCD = 8, WGM = 8;

__host__ __device__ __forceinline__ int lds_byte(int r, int c) { const int st = (r >> 4) * 2 + (c >> 5), rr = r & 15, cc = c & 31, ob = rr * 64 + cc * 2; return st * 1024 + (ob ^ (((ob >> 9) & 1) << 5)); }
__host__ __device__ __forceinline__ void stage_rc(int b, int& R, int& C) { const int st = b / 1024, sb = b % 1024, swz = sb ^ (((sb >> 9) & 1) << 5); R = (st >> 1) * 16 + swz / 64; C = (st & 1) * 32 + (swz % 64) / 2; }
struct Unit { int pm, pn, ord; };
struct Gemm { const half_t* A; const half_t* Bt; int M, N, K; };

struct StaticOrder {
    int nM, nN, nwg, G, c;
    __host__ __device__ void init(int M, int N, int G_, int c_) { nM = M / BM; nN = N / BM; nwg = nM * nN; G = G_; c = c_; }
    __host__ __device__ bool next(int i, Unit& u) const {
        const long L = (long)i * G + c; if (L >= nwg) return false;
        int wgid = (int)L; { const int q = nwg / NXCD, r = nwg % NXCD, xcd = wgid % NXCD, off = wgid / NXCD; wgid = (xcd < r ? xcd * (q + 1) : r * (q + 1) + (xcd - r) * q) + off; }
        const int nig = WGM * nN, gid = wgid / nig, fm = gid * WGM, gsz = (nM - fm) < WGM ? (nM - fm) : WGM;
        u.pm = fm + ((wgid % nig) % gsz); u.pn = (wgid % nig) / gsz; u.ord = i; return true;
    }
    __device__ __forceinline__ void a_ready(const Unit&) const {}
    __device__ __forceinline__ void done(const Unit&) const {}
};

template <class Epi, class Sched, bool ALIGN_EPI = false, bool SP2 = false>
__device__ __forceinline__ void gemm_phase(PG8_LAS unsigned char* lds, const Gemm g, const Sched& S, const Epi& E, int tid_in) {
    int tid_ = tid_in; asm volatile("" : "+v"(tid_));
    const int tid = tid_, wid = __builtin_amdgcn_readfirstlane(tid >> 6), lane = tid & 63, wr = wid >> 2, wc = wid & 3, fr = lane & 15, fq = lane >> 4;
    int K_ = g.K; asm volatile("" : "+s"(K_));
    const int K = K_, nt = K / BK;
    unsigned voffA[2], voffB[2];
#pragma unroll
    for (int i = 0; i < 2; ++i) { int R, C; stage_rc(tid * 16 + i * 8192, R, C); const int Rb = Epi::PERM ? ((R & ~31) + perm32(R & 31)) : R;
        voffA[i] = (unsigned)(R * K + C) * 2u; voffB[i] = (unsigned)(Rb * K + C) * 2u; }
    const size_t kstep = (size_t)(BK * 2);
    const size_t hstep = (size_t)HALF * K * 2;
    const size_t tstep = 2 * hstep;
    const unsigned ldsw = (unsigned)wid * 1024u;
    const int aoff = lds_byte(wr * 64 + fr, fq * 8), boff = lds_byte(wc * 32 + fr, fq * 8);
#define PG8_SA(b, h) (((b) * 2 + (h)) * HTB)
#define PG8_SB(b, h) ((4 + (b) * 2 + (h)) * HTB)
#define PG8_STAGE(bufoff, gbase, voff) do { _Pragma("unroll") for (int _i = 0; _i < 2; ++_i) \
        __builtin_amdgcn_global_load_lds((const unsigned*)((const char*)(gbase) + (voff)[_i]), (PG8_LAS unsigned*)(lds + (bufoff) + ldsw + _i * 8192), 16, 0, 0); } while (0)
#define PG8_LDA(dst, b, h) do { _Pragma("unroll") for (int m = 0; m < 4; ++m) _Pragma("unroll") for (int k = 0; k < 2; ++k) dst[m][k] = *(const PG8_LAS h8*)(lds + PG8_SA(b, h) + aoff + m * 2048 + k * 1024); } while (0)
#define PG8_LDB(dst, b, h) do { _Pragma("unroll") for (int n = 0; n < 2; ++n) _Pragma("unroll") for (int k = 0; k < 2; ++k) dst[n][k] = *(const PG8_LAS h8*)(lds + PG8_SB(b, h) + boff + n * 2048 + k * 1024); } while (0)
#define PG8_MMA(ai, bj, At, Bt) do { __builtin_amdgcn_s_setprio(1); _Pragma("unroll") for (int m = 0; m < 4; ++m) _Pragma("unroll") for (int n = 0; n < 2; ++n) _Pragma("unroll") for (int k = 0; k < 2; ++k) \
        acc[ai][bj][m][n] = __builtin_amdgcn_mfma_f32_16x16x32_f16(Bt[n][k], At[m][k], acc[ai][bj][m][n], 0, 0, 0); __builtin_amdgcn_s_setprio(0); } while (0)
#define PG8_WAIT_V(n) asm volatile("s_waitcnt vmcnt(" #n ")" ::: "memory")
#define PG8_WAIT_L(n) asm volatile("s_waitcnt lgkmcnt(" #n ")" ::: "memory")
#define PG8_BAR __builtin_amdgcn_s_barrier()
#define PG8_SCHED __builtin_amdgcn_sched_barrier(0)
    Unit cur, nxt; int ui = 0;
    if (!S.next(0, cur)) return;
    f32x4 acc[2][2][4][2];
    float z0_ = zf();
#pragma unroll
    for (int a = 0; a < 2; ++a)
#pragma unroll
        for (int b = 0; b < 2; ++b)
#pragma unroll
            for (int m = 0; m < 4; ++m)
#pragma unroll
                for (int n = 0; n < 2; ++n) acc[a][b][m][n] = (f32x4){z0_, z0_, z0_, z0_};
    h8 At[4][2], B0[2][2], B1[2][2];
    const char* cA = (const char*)g.A + (size_t)cur.pm * tstep; const char* cB = (const char*)g.Bt + (size_t)cur.pn * tstep;
    S.a_ready(cur);
    if constexpr (SP2) {
        PG8_STAGE(PG8_SB(0, 0), cB, voffB); PG8_STAGE(PG8_SB(0, 1), cB + hstep, voffB); PG8_STAGE(PG8_SA(0, 0), cA, voffA); PG8_STAGE(PG8_SA(0, 1), cA + hstep, voffA);
        if (wr == 1) PG8_BAR;
        PG8_WAIT_V(2); PG8_BAR;
        PG8_STAGE(PG8_SB(1, 0), cB + kstep, voffB); PG8_STAGE(PG8_SA(1, 0), cA + kstep, voffA); PG8_STAGE(PG8_SB(1, 1), cB + hstep + kstep, voffB);
        PG8_WAIT_V(6); PG8_BAR;
    } else {
        PG8_STAGE(PG8_SB(0, 0), cB, voffB); PG8_STAGE(PG8_SA(0, 0), cA, voffA); PG8_STAGE(PG8_SB(0, 1), cB + hstep, voffB); PG8_STAGE(PG8_SA(0, 1), cA + hstep, voffA);
        if (wr == 1) PG8_BAR;
        PG8_WAIT_V(4); PG8_BAR;
        PG8_STAGE(PG8_SB(1, 0), cB + kstep, voffB); PG8_STAGE(PG8_SA(1, 0), cA + kstep, voffA); PG8_STAGE(PG8_SB(1, 1), cB + hstep + kstep, voffB);
        PG8_WAIT_V(6); PG8_BAR;
    }
    for (;;) {
        const bool has_next = S.next(ui + 1, nxt);
        const char* nA = has_next ? (const char*)g.A + (size_t)nxt.pm * tstep : cA; const char* nB = has_next ? (const char*)g.Bt + (size_t)nxt.pn * tstep : cB;
        for (int t = 0; t < nt; t += 2) {
            const bool last = (t == nt - 2);
            const char* a1 = cA + (size_t)(t + 1) * kstep;
            const char* a2 = last ? nA : cA + (size_t)(t + 2) * kstep; const char* b2 = last ? nB : cB + (size_t)(t + 2) * kstep;
            const char* a3 = a2 + kstep; const char* b3 = b2 + kstep;
            if (last && has_next) S.a_ready(nxt);
            if constexpr (SP2) {
            PG8_LDB(B0, 0, 0); PG8_LDB(B1, 0, 1); PG8_SCHED; PG8_LDA(At, 0, 0); PG8_STAGE(PG8_SA(1, 1), a1 + hstep, voffA);
            PG8_WAIT_V(8); PG8_WAIT_L(0); PG8_BAR; PG8_MMA(0, 0, At, B0); PG8_MMA(0, 1, At, B1); PG8_BAR; PG8_SCHED;
            PG8_LDA(At, 0, 1); PG8_STAGE(PG8_SB(0, 0), b2, voffB); PG8_STAGE(PG8_SB(0, 1), b2 + hstep, voffB); PG8_STAGE(PG8_SA(0, 0), a2, voffA);
            PG8_WAIT_V(8); PG8_WAIT_L(0); PG8_BAR; PG8_MMA(1, 0, At, B0); PG8_MMA(1, 1, At, B1); PG8_BAR; PG8_SCHED;
            PG8_LDB(B0, 1, 0); PG8_LDB(B1, 1, 1); PG8_SCHED; PG8_LDA(At, 1, 0); PG8_STAGE(PG8_SA(0, 1), a2 + hstep, voffA);
            PG8_WAIT_V(8); PG8_WAIT_L(0); PG8_BAR; PG8_MMA(0, 0, At, B0); PG8_MMA(0, 1, At, B1); PG8_BAR; PG8_SCHED;
            PG8_LDA(At, 1, 1); PG8_STAGE(PG8_SB(1, 0), b3, voffB); PG8_STAGE(PG8_SB(1, 1), b3 + hstep, voffB); PG8_STAGE(PG8_SA(1, 0), a3, voffA);
            PG8_WAIT_V(8); PG8_WAIT_L(0); PG8_BAR; PG8_MMA(1, 0, At, B0); PG8_MMA(1, 1, At, B1); PG8_BAR; PG8_SCHED;
            } else {
            PG8_LDB(B0, 0, 0); PG8_SCHED; PG8_LDA(At, 0, 0); PG8_STAGE(PG8_SA(1, 1), a1 + hstep, voffA);
            PG8_WAIT_L(8); PG8_BAR; PG8_WAIT_L(0); PG8_MMA(0, 0, At, B0); PG8_BAR; PG8_SCHED;
            PG8_LDB(B1, 0, 1); PG8_STAGE(PG8_SB(0, 0), b2, voffB);
            PG8_BAR; PG8_WAIT_L(0); PG8_MMA(0, 1, At, B1); PG8_BAR;
            PG8_LDA(At, 0, 1); PG8_STAGE(PG8_SA(0, 0), a2, voffA);
            PG8_BAR; PG8_WAIT_L(0); PG8_MMA(1, 0, At, B0); PG8_BAR; PG8_SCHED;
            PG8_STAGE(PG8_SB(0, 1), b2 + hstep, voffB);
            PG8_WAIT_V(6); PG8_BAR; PG8_MMA(1, 1, At, B1); PG8_BAR;
            PG8_LDB(B0, 1, 0); PG8_SCHED; PG8_LDA(At, 1, 0); PG8_STAGE(PG8_SA(0, 1), a2 + hstep, voffA);
            PG8_WAIT_L(8); PG8_BAR; PG8_WAIT_L(0); PG8_MMA(0, 0, At, B0); PG8_BAR; PG8_SCHED;
            PG8_LDB(B1, 1, 1); PG8_STAGE(PG8_SB(1, 0), b3, voffB);
            PG8_BAR; PG8_WAIT_L(0); PG8_MMA(0, 1, At, B1); PG8_BAR;
            PG8_LDA(At, 1, 1); PG8_STAGE(PG8_SA(1, 0), a3, voffA);
            PG8_BAR; PG8_WAIT_L(0); PG8_MMA(1, 0, At, B0); PG8_BAR; PG8_SCHED;
            PG8_STAGE(PG8_SB(1, 1), b3 + hstep, voffB);
            PG8_WAIT_V(6); PG8_BAR; PG8_MMA(1, 1, At, B1); PG8_BAR;
            }
        }
        if constexpr (ALIGN_EPI) { if (wr == 0) PG8_BAR; }
        if constexpr (!Epi::AFTER_DRAIN) { E(acc, cur, wr, wc, fr, fq); S.done(cur); }
        if (!has_next) break;
        z0_ = zf();
#pragma unroll
        for (int a = 0; a < 2; ++a)
#pragma unroll
            for (int b = 0; b < 2; ++b)
#pragma unroll
                for (int m = 0; m < 4; ++m)
#pragma unroll
                    for (int n = 0; n < 2; ++n) acc[a][b][m][n] = (f32x4){z0_, z0_, z0_, z0_};
        cur = nxt; cA = nA; cB = nB; ++ui;
        if constexpr (ALIGN_EPI) { if (wr == 1) PG8_BAR; }
    }
    PG8_WAIT_V(0);
    if constexpr (!ALIGN_EPI) { if (wr == 0) PG8_BAR; }
    PG8_BAR;
    if constexpr (Epi::AFTER_DRAIN) { E.fused(acc, cur, wr, wc, fr, fq, lds, wid, lane); S.done(cur); }
#undef PG8_SA
#undef PG8_SB
#undef PG8_STAGE
#undef PG8_LDA
#undef PG8_LDB
#undef PG8_MMA
#undef PG8_WAIT_V
#undef PG8_WAIT_L
#undef PG8_BAR
#undef PG8_SCHED
}
}

namespace epi {
using pg8::Unit; using pg8::BM; using pg8::HALF;
typedef f32x4 Acc[2][2][4][2];
constexpr int SROW_OFF = MISC_OFF + 128, SROW_MAX_UNITS = 15;
static_assert(SROW_OFF + SROW_MAX_UNITS * 1024 <= LDS_BYTES, "row-scale table fits the LDS reservation");

template <int NP> __device__ __forceinline__ float row_ss(const float* P, int row) {
    if constexpr (NP == 1) return P[row];
    else { float s = 0.f;
#pragma unroll
        for (int i = 0; i < NP / 4; ++i) { const f32x4 v = *(const f32x4*)(P + (size_t)row * NP + 4 * i); s += (v[0] + v[1]) + (v[2] + v[3]); }
        return s; }
}
__device__ __forceinline__ float rs_from(float ss, float inv_dim) { return 1.0f / sqrtf(ss * inv_dim + EPS); }
template <class Sched> __device__ __forceinline__ void prep_srow(LAS unsigned char* lds, const float* SS, const Sched& So, int tid) {
    LAS float* tab = (LAS float*)(lds + SROW_OFF);
    Unit u;
    for (int i = 0; i < SROW_MAX_UNITS; ++i) { if (!So.next(i, u)) break;
        if (tid < 256) { const int row = u.pm * BM + tid; tab[i * 256 + tid] = rs_from(row_ss<16>(SS, row), 1.0f / 1024.0f); } }
    __syncthreads();
}
__device__ __forceinline__ void st8(half_t* p, f32x4 a, f32x4 b, float s) {
    u32x4 w; w.x = pkh(a[0] * s, a[1] * s); w.y = pkh(a[2] * s, a[3] * s); w.z = pkh(b[0] * s, b[1] * s); w.w = pkh(b[2] * s, b[3] * s);
    *(u32x4*)p = w;
}
__device__ __forceinline__ void st4(half_t* p, f32x4 a) { u32x2 w; w.x = pkh(a[0], a[1]); w.y = pkh(a[2], a[3]); *(u32x2*)p = w; }
__device__ __forceinline__ void rope_st(half_t* p1, half_t* p2, f32x4 x1, f32x4 x2, float s, const float* ctab, const float* stab) {
    const f32x4 c = *(const f32x4*)ctab, sn = *(const f32x4*)stab;
    x1 = x1 * s; x2 = x2 * s;
    st4(p1, x1 * c - x2 * sn); st4(p2, x2 * c + x1 * sn);
}

template <int XM = 0> struct EpiUpT {
    static constexpr bool PERM = false, AFTER_DRAIN = false;
    unsigned char* ws; LAS unsigned char* lds;
    __device__ __forceinline__ void operator()(const Acc& acc, const Unit& u_, int wr, int wc, int fr, int fq) const {
        Unit u = u_; asm volatile("" : "+s"(u.pm), "+s"(u.pn), "+s"(u.ord)); { int ln_; asm volatile("v_mbcnt_lo_u32_b32 %0, -1, 0\n\tv_mbcnt_hi_u32_b32 %0, -1, %0" : "=v"(ln_)); fr = ln_ & 15; fq = ln_ >> 4; }
        half_t* H = (half_t*)(ws + (XM ? WS_END : WS_HID)); if (XM) u.pm = 0; const LAS float* stab = (const LAS float*)(lds + SROW_OFF) + u.ord * 256;
#pragma unroll
        for (int ai = 0; ai < 2; ++ai)
#pragma unroll
            for (int m = 0; m < 4; ++m) {
                const int row = u.pm * BM + ai * HALF + wr * 64 + m * 16 + fr;
                const float s = stab[ai * HALF + wr * 64 + m * 16 + fr];
                float v[8];
#pragma unroll
                for (int n = 0; n < 2; ++n)
#pragma unroll
                    for (int j = 0; j < 4; ++j) {
                        const float g = acc[ai][0][m][n][j] * s, up = acc[ai][1][m][n][j] * s;
                        v[4 * n + j] = (XM == 2 || XM == 3 || XM == 5) ? g * up : g * __builtin_amdgcn_rcpf(1.0f + __expf(-g)) * up;
                    }
                u32x4 w; w.x = pkh(v[0], v[1]); w.y = pkh(v[2], v[3]); w.z = pkh(v[4], v[5]); w.w = pkh(v[6], v[7]);
                if (XM != 5 || w.x == 0x12345678u) *(u32x4*)(H + (size_t)row * DFF + 128 * u.pn + 32 * wc + 8 * fq) = w;
            }
    }
};

typedef EpiUpT<0> EpiUp;

struct EpiRes {
    static constexpr bool PERM = false, AFTER_DRAIN = false;
    unsigned char* ws; float alpha;
    __device__ __forceinline__ void operator()(const Acc& acc, const Unit& u_, int wr, int wc, int fr, int fq) const {
        Unit u = u_; asm volatile("" : "+s"(u.pm), "+s"(u.pn), "+s"(u.ord)); { int ln_; asm volatile("v_mbcnt_lo_u32_b32 %0, -1, 0\n\tv_mbcnt_hi_u32_b32 %0, -1, %0" : "=v"(ln_)); fr = ln_ & 15; fq = ln_ >> 4; }
        half_t* XN = (half_t*)(ws + WS_XN); float* SS = (float*)(ws + WS_SS);
#pragma unroll
        for (int ai = 0; ai < 2; ++ai) {
            h8 xo[4][2];
#pragma unroll
            for (int m = 0; m < 4; ++m)
#pragma unroll
                for (int bj = 0; bj < 2; ++bj)
                    xo[m][bj] = *(const h8*)(XN + (size_t)(u.pm * BM + ai * HALF + wr * 64 + m * 16 + fr) * D + u.pn * BM + bj * HALF + 32 * wc + 8 * fq);
            asm volatile("" ::: "memory");
#pragma unroll
            for (int m = 0; m < 4; ++m) {
                const int row = u.pm * BM + ai * HALF + wr * 64 + m * 16 + fr;
                float q = 0.f;
#pragma unroll
                for (int bj = 0; bj < 2; ++bj) {
                    half_t* p = XN + (size_t)row * D + u.pn * BM + bj * HALF + 32 * wc + 8 * fq;
                    float x[8];
#pragma unroll
                    for (int j = 0; j < 4; ++j) { x[j] = (float)xo[m][bj][j] + acc[ai][bj][m][0][j] * alpha; x[4 + j] = (float)xo[m][bj][4 + j] + acc[ai][bj][m][1][j] * alpha; }
                    u32x4 w; w.x = pkh(x[0], x[1]); w.y = pkh(x[2], x[3]); w.z = pkh(x[4], x[5]); w.w = pkh(x[6], x[7]);
                    *(u32x4*)p = w;
                    const h8 xr = __builtin_bit_cast(h8, w);
#pragma unroll
                    for (int j = 0; j < 8; ++j) { const float v = (float)xr[j]; q = __builtin_fmaf(v, v, q); }
                }
                { const int ln_ = fr + 16 * fq; q += bperm_f(ln_ ^ 16, q); q += bperm_f(ln_ ^ 32, q); }
                if (fq == 0) SS[(size_t)row * 16 + 4 * u.pn + wc] = q;
            }
            asm volatile("" ::: "memory");
        }
    }
};

template <int NP> struct EpiScale {
    static constexpr bool PERM = false, AFTER_DRAIN = false;
    unsigned char* ws; LAS unsigned char* lds; size_t o_off, p_off; int ldo; float inv_dim, cscale;
    __device__ __forceinline__ void operator()(const Acc& acc, const Unit& u_, int wr, int wc, int fr, int fq) const {
        Unit u = u_; asm volatile("" : "+s"(u.pm), "+s"(u.pn), "+s"(u.ord)); { int ln_; asm volatile("v_mbcnt_lo_u32_b32 %0, -1, 0\n\tv_mbcnt_hi_u32_b32 %0, -1, %0" : "=v"(ln_)); fr = ln_ & 15; fq = ln_ >> 4; }
        half_t* O = (half_t*)(ws + o_off); const float* P = (const float*)(ws + p_off);
#pragma unroll
        for (int ai = 0; ai < 2; ++ai)
#pragma unroll
            for (int m = 0; m < 4; ++m) {
                const int row = u.pm * BM + ai * HALF + wr * 64 + m * 16 + fr;
                const float s = (NP == 16 ? ((const LAS float*)(lds + SROW_OFF))[u.ord * 256 + ai * HALF + wr * 64 + m * 16 + fr] : rs_from(row_ss<NP>(P, row), inv_dim)) * cscale;
#pragma unroll
                for (int bj = 0; bj < 2; ++bj) st8(O + (size_t)row * ldo + u.pn * BM + bj * HALF + 32 * wc + 8 * fq, acc[ai][bj][m][0], acc[ai][bj][m][1], s);
            }
    }
};

struct EpiUq {
    static constexpr bool PERM = false, AFTER_DRAIN = false;
    unsigned char* ws;
    __device__ __forceinline__ void operator()(const Acc& acc, const Unit& u_, int wr, int wc, int fr, int fq) const {
        Unit u = u_; asm volatile("" : "+s"(u.pm), "+s"(u.pn), "+s"(u.ord)); { int ln_; asm volatile("v_mbcnt_lo_u32_b32 %0, -1, 0\n\tv_mbcnt_hi_u32_b32 %0, -1, %0" : "=v"(ln_)); fr = ln_ & 15; fq = ln_ >> 4; }
        half_t* QUP = (half_t*)(ws + WS_QUP); const float* SSQ = (const float*)(ws + WS_SSQ);
        const float* COS16 = (const float*)(ws + WS_TAB); const float* SIN16 = COS16 + 2048 * 16;
        const float cs = 0.10206207261596575f * LOG2E;
#pragma unroll
        for (int bj = 0; bj < 2; ++bj) {
            const int g = 8 * u.pn + 4 * bj + wc;
            if (g >= 18) continue;
            const int head = g / 3, part = g - 3 * head;
#pragma unroll
            for (int ai = 0; ai < 2; ++ai)
#pragma unroll
                for (int m = 0; m < 4; ++m) {
                    const int row = u.pm * BM + ai * HALF + wr * 64 + m * 16 + fr;
                    const float s = rs_from(row_ss<4>(SSQ, row), 1.0f / 256.0f) * cs;
                    half_t* rp = QUP + (size_t)row * 576 + 96 * head;
                    if (part < 2) st8(rp + 32 * part + 8 * fq, acc[ai][bj][m][0], acc[ai][bj][m][1], s);
                    else { const int pos = row & (S - 1);
                        rope_st(rp + 64 + 4 * fq, rp + 80 + 4 * fq, acc[ai][bj][m][0], acc[ai][bj][m][1], s, COS16 + pos * 16 + 4 * fq, SIN16 + pos * 16 + 4 * fq); }
                }
        }
    }
};

struct EpiWin {
    static constexpr bool PERM = false, AFTER_DRAIN = false;
    unsigned char* ws; LAS unsigned char* lds;
    __device__ __forceinline__ void operator()(const Acc& acc, const Unit& u_, int wr, int wc, int fr, int fq) const {
        Unit u = u_; asm volatile("" : "+s"(u.pm), "+s"(u.pn), "+s"(u.ord)); { int ln_; asm volatile("v_mbcnt_lo_u32_b32 %0, -1, 0\n\tv_mbcnt_hi_u32_b32 %0, -1, %0" : "=v"(ln_)); fr = ln_ & 15; fq = ln_ >> 4; }
        const LAS float* stab = (const LAS float*)(lds + SROW_OFF) + u.ord * 256;
        half_t *QF = (half_t*)(ws + WS_QF), *KF = (half_t*)(ws + WS_KF), *VF = (half_t*)(ws + WS_VF), *MCQ = (half_t*)(ws + WS_MCQ), *MCKV = (half_t*)(ws + WS_MCKV), *DQ = (half_t*)(ws + WS_DQ),
               *DK = (half_t*)(ws + WS_DK), *DV = (half_t*)(ws + WS_DV), *DQI = (half_t*)(ws + WS_DQI), *DKI = (half_t*)(ws + WS_DKI), *KR = (half_t*)(ws + WS_KR);
        float *SMALL = (float*)(ws + WS_SMALL), *SSQ = (float*)(ws + WS_SSQ), *SSKV = (float*)(ws + WS_SSKV);
        const float* COS16 = (const float*)(ws + WS_TAB); const float *SIN16 = COS16 + 2048 * 16, *COS32 = COS16 + 2048 * 32, *SIN32 = COS16 + 2048 * 64;
        const float cq = 0.125f * LOG2E;
        float s8[2][4];
#pragma unroll
        for (int ai = 0; ai < 2; ++ai)
#pragma unroll
            for (int m = 0; m < 4; ++m) s8[ai][m] = stab[ai * HALF + wr * 64 + m * 16 + fr];
        const int rbase = u.pm * BM + wr * 64 + fr;
#define ROWS_BEGIN _Pragma("unroll") for (int ai = 0; ai < 2; ++ai) _Pragma("unroll") for (int m = 0; m < 4; ++m) { const int row = rbase + ai * HALF + m * 16; const float s = s8[ai][m]; (void)s;
#define ROWS_END asm volatile("" ::: "memory"); }
#define PLAIN(BJ, DST, LD, COL, SC) ROWS_BEGIN st8((DST) + (size_t)row * (LD) + (COL) + 8 * fq, acc[ai][BJ][m][0], acc[ai][BJ][m][1], s * (SC)); ROWS_END
        const int pn = u.pn;
        if (pn == 0) { PLAIN(0, QF, 384, 32 * wc, cq) PLAIN(1, QF, 384, 128 + 32 * wc, cq) }
        else if (pn == 1) { PLAIN(0, QF, 384, 256 + 32 * wc, cq) PLAIN(1, KF, 384, 32 * wc, 1.0f) }
        else if (pn == 2) { PLAIN(0, KF, 384, 128 + 32 * wc, 1.0f) PLAIN(1, KF, 384, 256 + 32 * wc, 1.0f) }
        else if (pn == 3) { PLAIN(0, VF, 384, 32 * wc, 1.0f) PLAIN(1, VF, 384, 128 + 32 * wc, 1.0f) }
        else if (pn == 4) {
            PLAIN(0, VF, 384, 256 + 32 * wc, 1.0f)
            ROWS_BEGIN
                const f32x4 a = acc[ai][1][m][0] * s, b = acc[ai][1][m][1] * s;
                st8(MCKV + (size_t)row * 128 + 32 * wc + 8 * fq, a, b, 1.0f);
                float q = (a[0] * a[0] + a[1] * a[1]) + (a[2] * a[2] + a[3] * a[3]) + (b[0] * b[0] + b[1] * b[1]) + (b[2] * b[2] + b[3] * b[3]);
                { const int ln_ = fr + 16 * fq; q += bperm_f(ln_ ^ 16, q); q += bperm_f(ln_ ^ 32, q); }
                if (fq == 0) SSKV[(size_t)row * 4 + wc] = q;
            ROWS_END
        } else if (pn == 5) {
            ROWS_BEGIN
                float q = 0.f;
#pragma unroll
                for (int bj = 0; bj < 2; ++bj) {
                    const f32x4 a = acc[ai][bj][m][0] * s, b = acc[ai][bj][m][1] * s;
                    st8(MCQ + (size_t)row * 256 + 128 * bj + 32 * wc + 8 * fq, a, b, 1.0f);
                    q += (a[0] * a[0] + a[1] * a[1]) + (a[2] * a[2] + a[3] * a[3]) + (b[0] * b[0] + b[1] * b[1]) + (b[2] * b[2] + b[3] * b[3]);
                }
                { const int ln_ = fr + 16 * fq; q += bperm_f(ln_ ^ 16, q); q += bperm_f(ln_ ^ 32, q); }
                if (fq == 0) SSQ[(size_t)row * 4 + wc] = q;
            ROWS_END
        } else if (pn == 6) {
            const int e1 = 16 * (wc & 1) + 4 * fq;
            ROWS_BEGIN
                const int pos = row & (S - 1);
                const f32x4 c = *(const f32x4*)(COS32 + pos * 32 + e1), sn = *(const f32x4*)(SIN32 + pos * 32 + e1);
#pragma unroll
                for (int bj = 0; bj < 2; ++bj) {
                    half_t* rp = DQ + (size_t)row * 256 + 64 * ((4 * bj + wc) >> 1) + e1;
                    const f32x4 x1 = acc[ai][bj][m][0] * (s * cq), x2 = acc[ai][bj][m][1] * (s * cq);
                    st4(rp, x1 * c - x2 * sn); st4(rp + 32, x2 * c + x1 * sn);
                }
            ROWS_END
        } else if (pn == 7) {
            ROWS_BEGIN
                const int pos = row & (S - 1);
                const f32x4 c = *(const f32x4*)(COS16 + pos * 16 + 4 * fq), sn = *(const f32x4*)(SIN16 + pos * 16 + 4 * fq);
#pragma unroll
                for (int bj = 0; bj < 2; ++bj) {
                    half_t* rp = DQI + (size_t)row * 256 + 32 * (4 * bj + wc) + 4 * fq;
                    const f32x4 x1 = acc[ai][bj][m][0] * s, x2 = acc[ai][bj][m][1] * s;
                    st4(rp, x1 * c - x2 * sn); st4(rp + 16, x2 * c + x1 * sn);
                }
            ROWS_END
        } else {
            if (wc < 2) { const int e1 = 16 * wc + 4 * fq;
                ROWS_BEGIN
                    const int pos = row & (S - 1); half_t* rp = DK + (size_t)row * 64 + e1;
                    rope_st(rp, rp + 32, acc[ai][0][m][0], acc[ai][0][m][1], s, COS32 + pos * 32 + e1, SIN32 + pos * 32 + e1);
                ROWS_END
            } else { PLAIN(0, DV, 64, 32 * (wc - 2), 1.0f) }
            if (wc < 2) { half_t* dst = wc == 0 ? KR : DKI;
                ROWS_BEGIN
                    const int pos = row & (S - 1); half_t* rp = dst + (size_t)row * 32 + 4 * fq;
                    rope_st(rp, rp + 16, acc[ai][1][m][0], acc[ai][1][m][1], s, COS16 + pos * 16 + 4 * fq, SIN16 + pos * 16 + 4 * fq);
                ROWS_END
            } else if (wc == 2) {
                ROWS_BEGIN
                    *(f32x4*)(SMALL + (size_t)row * 16 + 4 * fq) = acc[ai][1][m][0] * s;
                ROWS_END
            }
        }
#undef PLAIN
#undef ROWS_BEGIN
#undef ROWS_END
    }
};
}

struct Args { const float* in[22]; float* out; unsigned char* ws; };
typedef __attribute__((address_space(4))) const Args CArgs;
__device__ __forceinline__ CArgs* kargs() { CArgs* p = (CArgs*)__builtin_amdgcn_kernarg_segment_ptr(); asm volatile("" : "+s"(p)); return p; }
struct Frame {
    LAS unsigned char* lds;
    volatile LAS unsigned* MISC;
    gu32* ctl;
    unsigned char* ws;
    int tid, lane, wave, vcu, G;
};
enum { I_X = 0, I_MEM, I_F1N, I_F1WI, I_F1WO, I_MIXN, I_WIN, I_BF, I_QN, I_WUQ, I_KVN, I_WUKV, I_WOUT, I_XAN, I_MEMN, I_XWQ, I_XWKV, I_XWO, I_F2N, I_F2WI, I_F2WO, I_FINN };

__device__ __forceinline__ half_t* wl_ptr(unsigned char* ws, int layer, size_t off) { return (half_t*)(ws + WS_W + (size_t)layer * WL_STRIDE + off); }

__device__ __forceinline__ int src_perm(int nb) { return (nb & ~31) + perm32(nb & 31); }
__device__ __forceinline__ int src_swiglu(int nb) { const int pn = nb >> 8, bj = (nb >> 7) & 1, wc = (nb >> 5) & 3; return bj * DFF + 128 * pn + 32 * wc + perm32(nb & 31); }
__device__ __forceinline__ int src_uq(int nb) { const int g = nb >> 5, rho = nb & 31; if (g >= 18) return -1; return (g % 3 == 2) ? 32 * g + rho : 32 * g + perm32(rho); }
__device__ __forceinline__ int src_win(int nb) {
    const int g = nb >> 5, rho = nb & 31, p = perm32(rho), r64 = (rho & 15) + 32 * (rho >> 4);
    if (g < 12) return C_FQ + 32 * g + p;
    if (g < 24) return C_FK + 32 * (g - 12) + p;
    if (g < 36) return C_FV + 32 * (g - 24) + p;
    if (g < 40) return C_MCKV + 32 * (g - 36) + p;
    if (g < 48) return C_MCQ + 32 * (g - 40) + p;
    if (g < 56) return C_DQ + 64 * ((g - 48) >> 1) + 16 * ((g - 48) & 1) + r64;
    if (g < 64) return C_DQI + 32 * (g - 56) + rho;
    if (g < 66) return C_DK + 16 * (g - 64) + r64;
    if (g < 68) return C_DV + 32 * (g - 66) + p;
    if (g == 68) return C_MKR + rho;
    if (g == 69) return C_DKI + rho;
    if (g == 70) return rho < 6 ? C_FF + rho : (rho >= 8 && rho < 16) ? C_DWI + rho - 8 : -1;
    return -1;
}
struct ConvDesc { const float* W; const float* gain; half_t* Bt; int ldw, K, nblk, map; };
__device__ __forceinline__ void conv_desc(CArgs* A, unsigned char* ws, int it, ConvDesc& d, int& r_out) {
    constexpr int I_WI = 16 * 176, I_WO = 44 * 32, I_WINN = 16 * 72, I_UQ = 4 * 24, I_UKV = 2 * 24, I_OUT = 16 * 32, I_XQ = 16 * 16, I_XKV = 16 * 32, I_XO = 8 * 32;
    constexpr int PER_LAYER = 2 * I_WI + 2 * I_WO + I_WINN + I_UQ + I_UKV + I_OUT + I_XQ + I_XKV + I_XO;
    const int l = it / PER_LAYER; int r = it - l * PER_LAYER;
    int map = 0, iw = 0, ig = -1, ldw = 0, K = 0, nblk = 0; size_t woff = 0, wl = 0, goff = 0;
    if (r < I_WI) { map = 1; iw = I_F1WI; ig = I_F1N; ldw = 2 * DFF; K = D; nblk = 176; woff = (size_t)l * D * 2 * DFF; wl = WL_WI1; goff = l * D; }
    else if ((r -= I_WI) < I_WO) { iw = I_F1WO; ldw = D; K = DFF; nblk = 32; woff = (size_t)l * DFF * D; wl = WL_WO1; }
    else if ((r -= I_WO) < I_WINN) { map = 2; iw = I_WIN; ig = I_MIXN; ldw = DIN; K = D; nblk = 72; woff = (size_t)l * D * DIN; wl = WL_WIN; goff = l * D; }
    else if ((r -= I_WINN) < I_UQ) { map = 3; iw = I_WUQ; ig = I_QN; ldw = 576; K = 256; nblk = 24; woff = (size_t)l * 256 * 576; wl = WL_WUQ; goff = l * 256; }
    else if ((r -= I_UQ) < I_UKV) { iw = I_WUKV; ig = I_KVN; ldw = 768; K = 128; nblk = 24; woff = (size_t)l * 128 * 768; wl = WL_WUKV; goff = l * 128; }
    else if ((r -= I_UKV) < I_OUT) { iw = I_WOUT; ldw = D; K = D; nblk = 32; woff = (size_t)l * D * D; wl = WL_WOUT; }
    else if ((r -= I_OUT) < I_XQ) { iw = I_XWQ; ig = I_XAN; ldw = 512; K = D; nblk = 16; woff = (size_t)l * D * 512; wl = WL_XWQ; goff = l * D; }
    else if ((r -= I_XQ) < I_XKV) { iw = I_XWKV; ig = I_MEMN; ldw = 1024; K = D; nblk = 32; woff = (size_t)l * D * 1024; wl = WL_XWKV; goff = l * D; }
    else if ((r -= I_XKV) < I_XO) { iw = I_XWO; ldw = D; K = 512; nblk = 32; woff = (size_t)l * 512 * D; wl = WL_XWO; }
    else if ((r -= I_XO) < I_WI) { map = 1; iw = I_F2WI; ig = I_F2N; ldw = 2 * DFF; K = D; nblk = 176; woff = (size_t)l * D * 2 * DFF; wl = WL_WI2; goff = l * D; }
    else { r -= I_WI; iw = I_F2WO; ldw = D; K = DFF; nblk = 32; woff = (size_t)l * DFF * D; wl = WL_WO2; }
    d.W = A->in[iw] + woff; d.gain = ig >= 0 ? A->in[ig] + goff : nullptr; d.Bt = wl_ptr(ws, l, wl); d.ldw = ldw; d.K = K; d.nblk = nblk; d.map = map; r_out = r;
}
__device__ __forceinline__ void conv_load(const ConvDesc& d, int item, int lane, float (&v)[32]) {
    const int kb = item / d.nblk, nb = item % d.nblk, k0 = 64 * kb, n0 = 32 * nb;
    const int nbrow = n0 + (lane & 31);
    const int sc = d.map == 0 ? src_perm(nbrow) : d.map == 1 ? src_swiglu(nbrow) : d.map == 2 ? src_win(nbrow) : src_uq(nbrow);
    const float* wp = d.W + (size_t)(k0 + (lane >> 5)) * d.ldw + (sc >= 0 ? sc : 0);
#pragma unroll
    for (int i = 0; i < 32; ++i) v[i] = wp[(size_t)(2 * i) * d.ldw];
    if (d.gain) {
        const float* gp = d.gain + k0 + (lane >> 5);
        float g[32];
#pragma unroll
        for (int i = 0; i < 32; ++i) g[i] = gp[2 * i];
#pragma unroll
        for (int i = 0; i < 32; ++i) v[i] *= g[i];
    }
    if (sc < 0) {
#pragma unroll
        for (int i = 0; i < 32; ++i) v[i] = 0.f;
    }
}
__device__ __forceinline__ void conv_store(const ConvDesc& d, int item, int lane, const float (&v)[32], LAS float* scr) {
    const int kb = item / d.nblk, nb = item % d.nblk, k0 = 64 * kb, n0 = 32 * nb;
#pragma unroll
    for (int i = 0; i < 32; ++i) scr[(2 * i + (lane >> 5)) * 33 + (lane & 31)] = v[i];
    LDS_WAIT(); asm volatile("" ::: "memory");
    const int c = lane & 7;
#pragma unroll
    for (int j = 0; j < 4; ++j) { const int n = (lane >> 3) + 8 * j; const LAS float* s = scr + (8 * c) * 33 + n;
        u32x4 o; o.x = pkh(s[0 * 33], s[1 * 33]); o.y = pkh(s[2 * 33], s[3 * 33]); o.z = pkh(s[4 * 33], s[5 * 33]); o.w = pkh(s[6 * 33], s[7 * 33]);
        *(GAS u32x4*)(d.Bt + (size_t)(n0 + n) * d.K + k0 + 8 * c) = o; }
    LDS_WAIT(); asm volatile("" ::: "memory");
}

template <int PARTS = 7> __device__ __forceinline__ void p0_prologue(Frame& F, CArgs* A) {
    LAS float* scr = (LAS float*)(F.lds + F.wave * 16384);
    const int gw = F.vcu * NWAVES + F.wave, NGW = F.G * NWAVES;
    if (PARTS & 1) {
        constexpr int NITEMS = 2 * (2 * 16 * 176 + 2 * 44 * 32 + 16 * 72 + 4 * 24 + 2 * 24 + 16 * 32 + 16 * 16 + 16 * 32 + 8 * 32);
        float va[32], vb[32]; ConvDesc da, db; int ra = 0, rb = 0;
        int it = gw;
        if (it < NITEMS) { conv_desc(A, F.ws, it, da, ra); conv_load(da, ra, F.lane, va); }
        while (it < NITEMS) {
            const int itb = it + NGW;
            if (itb < NITEMS) { conv_desc(A, F.ws, itb, db, rb); conv_load(db, rb, F.lane, vb); }
            conv_store(da, ra, F.lane, va, scr);
            if (itb >= NITEMS) break;
            const int ita = itb + NGW;
            if (ita < NITEMS) { conv_desc(A, F.ws, ita, da, ra); conv_load(da, ra, F.lane, va); }
            conv_store(db, rb, F.lane, vb, scr);
            it = ita;
        }
    }
    if (PARTS & 2) {
        float* tab = (float*)(F.ws + WS_TAB);
        float* COS16 = tab, *SIN16 = tab + 2048 * 16, *COS32 = tab + 2048 * 32, *SIN32 = tab + 2048 * 64;
        const int gt = F.vcu * NTHREADS + F.tid;
        if (gt < 2048 * 48) {
            const int pos = gt / 48, e = gt % 48;
            const int half = e < 16 ? 16 : 32, i = e < 16 ? e : e - 16;
            const float inv = powf(10000.0f, -(float)i / (float)half);
            const float ang = (float)pos * inv;
            const float c = cosf(ang), s = sinf(ang);
            if (e < 16) { COS16[pos * 16 + i] = c; SIN16[pos * 16 + i] = s; } else { COS32[pos * 32 + i] = c; SIN32[pos * 32 + i] = s; }
        }
    }
    if (PARTS & 4) for (int m0 = gw; m0 < M + MM; m0 += 4 * NGW) {
        f32x4 v[4][4]; float s[4] = {0.f, 0.f, 0.f, 0.f};
#pragma unroll
        for (int u = 0; u < 4; ++u) { const int m = m0 + u * NGW; if (m < M + MM) { const bool isx = m < M; const int r = isx ? m : m - M;
            const GAS f32x4* xr = (const GAS f32x4*)((isx ? A->in[I_X] : A->in[I_MEM]) + (size_t)r * D) + F.lane;
#pragma unroll
            for (int j = 0; j < 4; ++j) v[u][j] = xr[64 * j]; } }
#pragma unroll
        for (int u = 0; u < 4; ++u) { const int m = m0 + u * NGW; if (m < M + MM) { const bool isx = m < M; const int r = isx ? m : m - M;
            half_t* orow = (half_t*)(F.ws + (isx ? WS_XN : WS_MEMB)) + (size_t)r * D;
#pragma unroll
            for (int j = 0; j < 4; ++j) s[u] += (v[u][j].x * v[u][j].x + v[u][j].y * v[u][j].y) + (v[u][j].z * v[u][j].z + v[u][j].w * v[u][j].w);
            s[u] = wave_sum(s[u]);
#pragma unroll
            for (int j = 0; j < 4; ++j) { u32x2 w; w.x = pkh(v[u][j].x, v[u][j].y); w.y = pkh(v[u][j].z, v[u][j].w); *((GAS u32x2*)orow + F.lane + 64 * j) = w; }
            if (isx) { if (F.lane < 16) ((float*)(F.ws + WS_SS))[(size_t)r * 16 + F.lane] = F.lane == 0 ? s[u] : 0.f; }
            else if (F.lane == 0) ((float*)(F.ws + WS_MEMSS))[r] = s[u]; } }
    }
}

__device__ __forceinline__ float logsig(float z) { const float e = __builtin_amdgcn_exp2f(-__builtin_fabsf(z) * LOG2E); return fminf(z, 0.f) - __builtin_amdgcn_logf(1.0f + e) * 0.6931471805599453f; }
__device__ __forceinline__ void scan_seq(const float* SMALL, const float* bfg, float* CUM, int seq, int lane) {
    const int b = seq / 6, h = seq - 6 * b;
    const float* src = SMALL + ((size_t)b * S + 32 * lane) * 16 + h;
    const float bias = bfg[h];
    float v[32];
#pragma unroll
    for (int i = 0; i < 32; ++i) v[i] = src[i * 16];
    float run = 0.f;
#pragma unroll
    for (int i = 0; i < 32; ++i) { run += logsig(v[i] + bias); v[i] = run; }
    float inc = run;
#pragma unroll
    for (int o = 1; o < 64; o <<= 1) { const float t = bperm_f(lane >= o ? lane - o : lane, inc); if (lane >= o) inc += t; }
    const float off = inc - run;
    float* dst = CUM + (size_t)seq * S + 32 * lane;
#pragma unroll
    for (int i = 0; i < 8; ++i) { const f32x4 w = {(v[4 * i] + off) * LOG2E, (v[4 * i + 1] + off) * LOG2E, (v[4 * i + 2] + off) * LOG2E, (v[4 * i + 3] + off) * LOG2E}; *(f32x4*)(dst + 4 * i) = w; }
}

namespace dsa {
constexpr int QSTR = 1028  , HIST_BYTES = 16 * QSTR * 4;
constexpr int LIST_WORDS = 2048, STAGE_OFF = MISC_OFF + 128, STAGE_BYTES = 4096, QS_OFF = STAGE_OFF + STAGE_BYTES, FLAG_OFF = QS_OFF + 16 * 16, CNT_OFF = FLAG_OFF + 16, DUMMY_OFF = CNT_OFF + 64;
static_assert(DUMMY_OFF + 512 * 4 <= LDS_BYTES && 16 * LIST_WORDS * 4 <= RING_BYTES && HIST_BYTES <= RING_BYTES, "DSA threshold LDS map");
__device__ __forceinline__ unsigned fkey(float f) { const unsigned u = __float_as_uint(f); return u ^ ((unsigned)((int)u >> 31) | 0x80000000u); }

__device__ __forceinline__ unsigned comp_of(unsigned k, int s) { return ((k & 0x1FFFFFu) << 11) | (unsigned)(2047 - s); }

template <int PASS>
__device__ __forceinline__ void thr_pass(Frame& F, int qt, const unsigned (&key)[16][4], LAS unsigned* hist, LAS unsigned* stage, LAS unsigned* qs, LAS unsigned* flag) {
    int ln_; asm volatile("v_mbcnt_lo_u32_b32 %0, -1, 0\n\tv_mbcnt_hi_u32_b32 %0, -1, %0" : "=v"(ln_));
    const int lane = ln_, w = F.wave, tid = w * 64 + lane, qc = lane & 15, kg = lane >> 4;
    const unsigned D1 = qs[qc * 4 + 0], Cstar = qs[qc * 4 + 2];
    const unsigned Kstar = (D1 << 21) | (Cstar >> 11);
    const int sstar = Kstar != 0u ? 2047 - (int)(Cstar & 2047u) : -1;
    const unsigned hbase = (unsigned)(qc * QSTR) * 4u;
    LAS unsigned char* lb = (LAS unsigned char*)hist;
#pragma unroll
    for (int i = 0; i < 16; ++i) {
        const int kt = w + 8 * i;
        if (kt > qt) continue;
        unsigned nib = 0u;
#pragma unroll
        for (int j = 0; j < 4; ++j) {
            const unsigned k = key[i][j];
            const int s = 16 * kt + 4 * kg + j;
            if (PASS == 0) {
                const unsigned dg = k >> 21;
                __hip_atomic_fetch_add((LAS unsigned*)(lb + hbase + ((dg >> 1) << 2)), (dg & 1u) ? 0x10000u : 1u, __ATOMIC_RELAXED, __HIP_MEMORY_SCOPE_WORKGROUP);
            } else {
                const bool sel = (k > Kstar) | ((k == Kstar) & (s <= sstar));
                nib |= sel ? (1u << j) : 0u;
            }
        }
        if (PASS == 4) __hip_atomic_fetch_or(stage + qc * 64 + (kt >> 1), nib << (16 * (kt & 1) + 4 * kg), __ATOMIC_RELAXED, __HIP_MEMORY_SCOPE_WORKGROUP);
    }
    __syncthreads();
    if (PASS == 0) {
        const int q = tid >> 5, j = tid & 31, hb = lane & 32;
        const LAS unsigned* wd = hist + q * QSTR + 32 * j;
        unsigned cnt = 0u;
#pragma unroll
        for (int i = 0; i < 8; ++i) { const u32x4 x = *(const LAS u32x4*)(wd + 4 * i);
            cnt += (x.x & 0xffffu) + (x.x >> 16) + (x.y & 0xffffu) + (x.y >> 16) + (x.z & 0xffffu) + (x.z >> 16) + (x.w & 0xffffu) + (x.w >> 16); }
        if (j == 0) cnt -= (wd[0] & 0xffffu);
        unsigned inc = cnt;
#pragma unroll
        for (int o = 1; o < 32; o <<= 1) { const unsigned t = bperm_u(j + o < 32 ? lane + o : lane, inc); if (j + o < 32) inc += t; }
        const unsigned suf = inc - cnt, R = 256u;
        const bool isx = suf < R && suf + cnt >= R;
        const unsigned long long bal = __builtin_amdgcn_ballot_w64(isx);
        const unsigned hm = hb ? (unsigned)(bal >> 32) : (unsigned)bal;
        const int jstar = hm ? (int)__builtin_ctz(hm) : 0;
        const unsigned sufstar = bperm_u(hb + jstar, suf);
        const unsigned x = hist[q * QSTR + 32 * jstar + j], lo = (jstar == 0 && j == 0) ? 0u : (x & 0xffffu), hi = x >> 16, pc = lo + hi;
        unsigned inc2 = pc;
#pragma unroll
        for (int o = 1; o < 32; o <<= 1) { const unsigned t = bperm_u(j + o < 32 ? lane + o : lane, inc2); if (j + o < 32) inc2 += t; }
        const unsigned c = sufstar + (inc2 - pc);
        const bool hitHi = c < R && c + hi >= R;
        const bool hitLo = !hitHi && c + hi < R && c + hi + lo >= R;
        if (hm != 0u && (hitHi || hitLo)) { qs[q * 4 + 0] = 64 * jstar + 2 * j + (hitHi ? 1 : 0); qs[q * 4 + 1] = R - (hitHi ? c : c + hi); }
        __syncthreads();
    }
}

__device__ __forceinline__ void thr_select(Frame& F, int qt, const unsigned (&key)[16][4], LAS unsigned* list, LAS unsigned* qs, LAS unsigned* cnt) {
    int ln_; asm volatile("v_mbcnt_lo_u32_b32 %0, -1, 0\n\tv_mbcnt_hi_u32_b32 %0, -1, %0" : "=v"(ln_));
    const int lane = ln_, w = F.wave, qc = lane & 15, kg = lane >> 4;
    const unsigned D1r = qs[qc * 4 + 0], D1 = D1r != 0u ? D1r : 0xffffffffu;
    unsigned nc = 0u;
#pragma unroll
    for (int i = 0; i < 16; ++i) {
        if (w + 8 * i > qt) continue;
#pragma unroll
        for (int j = 0; j < 4; ++j) { const unsigned k = key[i][j]; nc += ((k >> 21) == D1) ? 1u : 0u; } }
    unsigned pos = 0u;
    if (nc != 0u) pos = __hip_atomic_fetch_add(cnt + qc, nc, __ATOMIC_RELAXED, __HIP_MEMORY_SCOPE_WORKGROUP);
    { LAS unsigned* lq = list + qc * LIST_WORDS;
#pragma unroll
      for (int i = 0; i < 16; ++i) {
          const int kt = w + 8 * i;
          if (kt > qt) continue;
#pragma unroll
          for (int j = 0; j < 4; ++j) {
              const unsigned k = key[i][j];
              if ((k >> 21) == D1) { lq[pos] = comp_of(k, 16 * kt + 4 * kg + j); ++pos; }
          }
      } }
    __syncthreads();
    const int q = 2 * w + (lane >> 5), j = lane & 31;
    const unsigned n = cnt[q], R = qs[q * 4 + 1];
    const LAS unsigned* lq = list + q * LIST_WORDS;
    unsigned e[8];
#pragma unroll
    for (int t = 0; t < 8; ++t) e[t] = (unsigned)(j + 32 * t) < n ? lq[j + 32 * t] : 0u;
    const unsigned nmax = (unsigned)__builtin_amdgcn_readfirstlane((int)max(n, bperm_u(lane ^ 32, n)));
    unsigned T = 0u, cT = n;
    const bool upper = (lane & 32) != 0;
    for (int bit = 31; bit >= 0; --bit) {
        if (__builtin_amdgcn_ballot_w64(cT != R && n != 0u) == 0ull) break;
        const unsigned cand = T | (1u << bit);
        unsigned ca = 0u, cb = 0u;
#pragma unroll
        for (int t = 0; t < 8; ++t) { const unsigned long long m = __builtin_amdgcn_ballot_w64(e[t] >= cand);
            ca += (unsigned)__builtin_popcount((unsigned)m); cb += (unsigned)__builtin_popcount((unsigned)(m >> 32)); }
        for (unsigned t = 256u; t < nmax; t += 32u) { const unsigned tt = t + (unsigned)j; const unsigned long long m = __builtin_amdgcn_ballot_w64(tt < n && lq[tt < n ? tt : 0u] >= cand);
            ca += (unsigned)__builtin_popcount((unsigned)m); cb += (unsigned)__builtin_popcount((unsigned)(m >> 32)); }
        const unsigned c = upper ? cb : ca;
        if (c >= R && cT != R) { T = cand; cT = c; }
    }
    unsigned mn = 0xffffffffu;
#pragma unroll
    for (int t = 0; t < 8; ++t) { const bool v = (unsigned)(j + 32 * t) < n && e[t] >= T; mn = v ? min(mn, e[t]) : mn; }
    for (unsigned t = 256u; t < nmax; t += 32u) { const unsigned tt = t + (unsigned)j; const unsigned x = lq[tt < n ? tt : 0u]; if (tt < n && x >= T) mn = min(mn, x); }
#pragma unroll
    for (int o = 1; o < 32; o <<= 1) mn = min(mn, bperm_u(lane ^ o, mn));
    if (j == 0 && n != 0u) qs[q * 4 + 2] = mn;
    __syncthreads();
}

template <int XM = 0> __device__ __forceinline__ void thr_unit(Frame& F, int b, int qt, const half_t* DQI, const half_t* DKI, const float* SMALL, unsigned* MASK) {
    LAS unsigned* hist = (LAS unsigned*)F.lds;
    LAS unsigned* stage = (LAS unsigned*)(F.lds + STAGE_OFF);
    LAS unsigned* qs = (LAS unsigned*)(F.lds + QS_OFF);
    LAS unsigned* flag = (LAS unsigned*)(F.lds + FLAG_OFF);
    LAS unsigned* cnt = (LAS unsigned*)(F.lds + CNT_OFF);
    const int tid = F.tid, lane = F.lane, w = F.wave, qc = lane & 15, kg = lane >> 4;
    const size_t rowb = (size_t)b * S;
    if (16 * qt + 15 < 256) {
        const int q = tid >> 5, j = tid & 31, nw = (qt >> 1) + 1, tq = 16 * qt + q;
        if (j < nw) { const int rem = tq - 32 * j; MASK[(rowb + tq) * 64 + j] = rem >= 31 ? 0xffffffffu : rem < 0 ? 0u : ((2u << rem) - 1u); }
        return;
    }
    const int tq = 16 * qt + qc;
    const size_t qrow = rowb + tq;
    unsigned key[16][4];
    {
        h8 qh[8]; float wt[8];
        h8 ka[16];
#pragma unroll
        for (int i = 0; i < 16; ++i) { const int kt = w + 8 * i, ktc = kt <= qt ? kt : qt; ka[i] = *(const h8*)(DKI + (rowb + 16 * ktc + qc) * 32 + 8 * kg); }
        { const unsigned zz_ = ou(0u); const u32x4 zv_ = {zz_, zz_, zz_, zz_};
#pragma unroll
          for (int i = 0; i < 8; ++i) *(LAS u32x4*)((LAS unsigned char*)hist + (size_t)(tid + 512 * i) * 16) = zv_;
          if (tid < 16) *(LAS u32x4*)((LAS unsigned char*)hist + (size_t)(4096 + tid) * 16) = zv_;
          if (tid < 256) *(LAS u32x4*)((LAS unsigned char*)stage + tid * 16) = zv_; }
#pragma unroll
        for (int h = 0; h < 8; ++h) qh[h] = *(const h8*)(DQI + qrow * 256 + 32 * h + 8 * kg);
        { const f32x4 a = *(const f32x4*)(SMALL + qrow * 16 + 8), c = *(const f32x4*)(SMALL + qrow * 16 + 12);
          wt[0] = a[0]; wt[1] = a[1]; wt[2] = a[2]; wt[3] = a[3]; wt[4] = c[0]; wt[5] = c[1]; wt[6] = c[2]; wt[7] = c[3]; }
        h8 qlin;
#pragma unroll
        for (int j = 0; j < 8; ++j) { float a = 0.f;
#pragma unroll
            for (int h = 0; h < 8; ++h) a = __builtin_fmaf(wt[h], (float)qh[h][j], a);
            qlin[j] = (half_t)a; }
        const float z0_ = zf(); const f32x4 z = {z0_, z0_, z0_, z0_};
#pragma unroll
        for (int i = 0; i < 16; ++i) {
            const int kt = w + 8 * i;
            if (kt <= qt) {
                f32x4 acc = XM == 3 ? z : __builtin_amdgcn_mfma_f32_16x16x32_f16(ka[i], qlin, z, 0, 0, 0);
#pragma unroll
                for (int h = 0; h < (XM == 3 ? 1 : 8); ++h) { const f32x4 sc = __builtin_amdgcn_mfma_f32_16x16x32_f16(ka[i], qh[h], z, 0, 0, 0);
#pragma unroll
                    for (int j = 0; j < 4; ++j) acc[j] = __builtin_fmaf(__builtin_fabsf(sc[j]), wt[h], acc[j]); }
#pragma unroll
                for (int j = 0; j < 4; ++j) key[i][j] = (16 * kt + 4 * kg + j <= tq) ? fkey(acc[j]) : 0u;
            } else {
#pragma unroll
                for (int j = 0; j < 4; ++j) key[i][j] = 0u;
            }
        }
    }
    if (tid < 16) { qs[tid * 4 + 0] = ou(0u); qs[tid * 4 + 1] = ou(1u); qs[tid * 4 + 2] = ou(0u); qs[tid * 4 + 3] = ou(0u); cnt[tid] = ou(0u); }
    __syncthreads();
    if (XM != 1) { thr_pass<0>(F, qt, key, hist, stage, qs, flag);
    if (XM != 2) thr_select(F, qt, key, hist, qs, cnt); }
    thr_pass<4>(F, qt, key, hist, stage, qs, flag);
    { const int q = tid >> 5, j = tid & 31, nw = (qt >> 1) + 1;
      unsigned* dst = MASK + (rowb + 16 * qt + q) * 64;
      if (j < nw) dst[j] = stage[q * 64 + j];
      if (j + 32 < nw) dst[j + 32] = stage[q * 64 + j + 32]; }
    __syncthreads();
}
}

#ifndef MK_FOX_SKIP
#define MK_FOX_SKIP 1
#endif
namespace att {
enum { FOX = 0, MLA = 1, DSA = 2, XA = 3 };
template <int KIND> struct Cfg {
    static constexpr int DQK = KIND == MLA ? 96 : KIND == XA ? 128 : 64, DV = KIND == XA ? 128 : 64;
    static constexpr int KSTR = DQK * 2 + 16, VSTR = DV == 64 ? 192 : 320;
    static constexpr int KT = 64, KB = KT * KSTR, VB = KT * VSTR;
    static constexpr int NKC = KT * DQK / 8, NVC = KT * DV / 8, NCH = NKC + NVC, NL = (NCH + 511) / 512;
    static constexpr bool CAUSAL = KIND != XA;
};
struct UD { const half_t* Q; int qp; const half_t* K0; int kp0; const half_t* K1; int kp1; const half_t* V; int vp; half_t* O; int op; const float* cum; const unsigned* mask; unsigned* mask_dbg; int dbg_shift; const unsigned char* base; const float* kn; };

typedef short v4i16_t __attribute__((ext_vector_type(4)));
__device__ __forceinline__ s16x4 vtr(const LAS unsigned char* p) { return __builtin_bit_cast(s16x4, __builtin_amdgcn_ds_read_tr16_b64_v4i16((LAS v4i16_t*)p)); }
__device__ __forceinline__ float max3(float a, float b, float c) { return fmaxf(fmaxf(a, b), c); }
__device__ __forceinline__ float sub_s(float a, float b) { float r; asm("v_sub_f32_e32 %0, %1, %2" : "=v"(r) : "v"(a), "v"(b)); return r; }
__device__ __forceinline__ float add_s(float a, float b) { float r; asm("v_add_f32_e32 %0, %1, %2" : "=v"(r) : "v"(a), "v"(b)); return r; }
__device__ __forceinline__ void mul_ip(float& x, float a) { asm volatile("v_mul_f32_e32 %0, %0, %1" : "+v"(x) : "v"(a)); }
__device__ __forceinline__ void sub_ip(float& x, float a) { asm volatile("v_sub_f32_e32 %0, %0, %1" : "+v"(x) : "v"(a)); }
__device__ __forceinline__ void set_ip(float& x, float a) { asm volatile("v_mov_b32_e32 %0, %1" : "+v"(x) : "v"(a)); }

template <int KIND, int EXP = 0>
__device__ __forceinline__ void attn_unit(Frame& F, const UD& ud, size_t rowk, size_t rowq, int qb) {
    typedef Cfg<KIND> C;
    constexpr bool REV = (KIND == FOX);
    int tid_ = F.tid, lane_ = F.lane; asm volatile("" : "+v"(tid_), "+v"(lane_));
    const int tid = tid_, lane = lane_, w = F.wave, qi = lane & 31, hh = lane >> 5;
    LAS unsigned char* lds = F.lds;
    const int NT = EXP == 5 ? 1 : (C::CAUSAL ? 4 * qb + 4 : 4);
    const int tlim = C::CAUSAL ? 4 * qb + (w >> 1) : 3;
    const unsigned char* sp[C::NL]; int sstep[C::NL]; int ldo[C::NL]; bool sv[C::NL];
#pragma unroll
    for (int i = 0; i < C::NL; ++i) {
        const int c = tid + 512 * i; sv[i] = (C::NCH % 512 == 0) ? true : (c < C::NCH);
        const int cc = sv[i] ? c : 0;
        if (cc < C::NKC) { const int row = cc / (C::DQK / 8), c8 = cc % (C::DQK / 8);
            if (KIND == MLA && c8 >= 8) { sp[i] = (const unsigned char*)(ud.K1 + (rowk + row) * ud.kp1 + 8 * (c8 - 8)); sstep[i] = C::KT * ud.kp1 * 2; }
            else { sp[i] = (const unsigned char*)(ud.K0 + (rowk + row) * ud.kp0 + 8 * c8); sstep[i] = C::KT * ud.kp0 * 2; }
            ldo[i] = row * C::KSTR + c8 * 16;
        } else { const int cv = cc - C::NKC, row = cv / (C::DV / 8), c8 = cv % (C::DV / 8);
            sp[i] = (const unsigned char*)(ud.V + (rowk + row) * ud.vp + 8 * c8); sstep[i] = C::KT * ud.vp * 2;
            ldo[i] = 2 * C::KB + row * C::VSTR + c8 * 16; }
    }
    u32x4 stg[C::NL];
#define ATT_LOAD(R, t) do { _Pragma("unroll") for (int i = 0; i < C::NL; ++i) R[i] = *(const GAS u32x4*)(sp[i] + (size_t)(EXP == 1 ? 0 : (t)) * sstep[i]); } while (0)
#define ATT_WRITE(R, p) do { _Pragma("unroll") for (int i = 0; i < C::NL; ++i) if (sv[i]) *(LAS u32x4*)(lds + ldo[i] + ((ldo[i] >= 2 * C::KB) ? (p) * C::VB : (p) * C::KB)) = R[i]; } while (0)
    f32x4 cbn[2][4];
    ATT_LOAD(stg, REV ? NT - 1 : 0);
    if (KIND == FOX) { const float* cp = ud.cum + 64 * (NT - 1) + 4 * (lane >> 5);
#pragma unroll
        for (int j = 0; j < 2; ++j)
#pragma unroll
            for (int g = 0; g < 4; ++g) cbn[j][g] = *(const f32x4*)(cp + 32 * j + 8 * g); }
    h8 qf[C::DQK / 16];
    { const half_t* qp = ud.Q + (rowq + 32 * w + qi) * ud.qp + 8 * hh;
#pragma unroll
      for (int ks = 0; ks < C::DQK / 16; ++ks) qf[ks] = *(const h8*)(qp + 16 * ks); }
    LAS float* xq = (LAS float*)(lds + RING_BYTES + 128);
    float kpre = 0.f;
    if (REV) {
        float qq = 0.f;
#pragma unroll
        for (int ks = 0; ks < C::DQK / 16; ++ks)
#pragma unroll
            for (int e = 0; e < 8; ++e) { const float x = (float)qf[ks][e]; qq = __builtin_fmaf(x, x, qq); }
        qq += bperm_f(lane ^ 32, qq);
#pragma unroll
        for (int o = 1; o < 32; o <<= 1) qq = fmaxf(qq, bperm_f(lane ^ o, qq));
        if (lane == 0) xq[w] = qq;
        kpre = ud.kn[lane & 31];
#pragma unroll
        for (int o = 1; o < 32; o <<= 1) { const float t_ = bperm_f((lane & 31) >= o ? lane - o : lane, kpre); kpre = fmaxf(kpre, t_); }
    }
    float cnx = 0.f;
    float qn_ub = 0.f, mmin_blk = 0.f;
    float mref = 0.f, l_run = 0.f; bool init = false;
    f32x16 negm;
#pragma unroll
    for (int r = 0; r < 16; ++r) negm[r] = zf();
    u32x2 mwn = {0xffffffffu, 0xffffffffu};
    if (KIND == DSA) mwn = *(const u32x2*)(ud.mask + (size_t)(256 * qb + 32 * w + qi) * 64);
    f32x16 o[C::DV / 32]; const float zo_ = zf();
#pragma unroll
    for (int d0 = 0; d0 < C::DV / 32; ++d0)
#pragma unroll
        for (int r = 0; r < 16; ++r) o[d0][r] = zo_;
    ATT_WRITE(stg, 0);
#pragma unroll
    for (int ks = 0; ks < C::DQK / 16; ++ks) asm volatile("" :: "v"(qf[ks]));
    __syncthreads();
    const int kroff = qi * C::KSTR + hh * 16;
    const int vroff = 2 * C::KB + (4 * hh + ((lane & 15) >> 2)) * C::VSTR + (16 * ((lane >> 4) & 1) + 4 * (lane & 3)) * 2;
    const int qrel = 32 * w + qi;
    for (int it = 0; it < NT; ++it) {
        const int t = REV ? NT - 1 - it : it, tn = REV ? t - 1 : t + 1;
        const int p = it & 1;
        if (REV && it >= 4) {
            if (it == 4) { float a = xq[0], b_ = xq[8];
#pragma unroll
                for (int i = 1; i < 8; ++i) { a = fmaxf(a, xq[i]); b_ = fminf(b_, xq[8 + i]); }
                qn_ub = sqrtf(a) * 1.0001f; mmin_blk = b_; }
            const float ub = qn_ub * __int_as_float(__builtin_amdgcn_readlane(__float_as_int(kpre), t)) + 0.001f - cnx;
            if (ub < mmin_blk - 40.0f) break;
        }
        ATT_LOAD(stg, it + 1 < NT ? tn : t);
        if (REV) cnx = ud.cum[64 * (tn > 0 ? tn : 0) + 63];
        bool wrote = false;
        if (t <= tlim) {
            unsigned mw[2] = {0xffffffffu, 0xffffffffu};
            if (KIND == DSA) { mw[0] = mwn.x >> (4 * hh); mw[1] = mwn.y >> (4 * hh);
                if (t + 1 < NT) mwn = *(const u32x2*)(ud.mask + (size_t)(256 * qb + qrel) * 64 + 2 * (t + 1)); }
            f32x16 sT[2];
            const LAS unsigned char* kb = lds + p * C::KB + kroff;
            { f32x16 c0 = negm, c1 = negm;
              if (KIND == FOX) {
#pragma unroll
                  for (int r = 0; r < 16; ++r) { c0[r] = negm[r] - cbn[0][r >> 2][r & 3]; c1[r] = negm[r] - cbn[1][r >> 2][r & 3]; } }
              if (KIND == DSA) {
                  const unsigned ninf = ou(0xff800000u);
#pragma unroll
                  for (int r = 0; r < 16; ++r) { const int cr = (r & 3) + 8 * (r >> 2);
                      const unsigned m0 = ou((unsigned)__builtin_amdgcn_sbfe((int)mw[0], cr, 1)), m1 = ou((unsigned)__builtin_amdgcn_sbfe((int)mw[1], cr, 1));
                      c0[r] = __uint_as_float((__float_as_uint(negm[r]) & m0) | (ninf & ~m0));
                      c1[r] = __uint_as_float((__float_as_uint(negm[r]) & m1) | (ninf & ~m1)); } }
              h8 ka0 = *(const LAS h8*)(kb), ka1 = *(const LAS h8*)(kb + 32 * C::KSTR);
              h8 kb0 = *(const LAS h8*)(kb + 32), kb1 = *(const LAS h8*)(kb + 32 * C::KSTR + 32);
              __builtin_amdgcn_sched_barrier(0);
              sT[0] = __builtin_amdgcn_mfma_f32_32x32x16_f16(ka0, qf[0], c0, 0, 0, 0);
              sT[1] = __builtin_amdgcn_mfma_f32_32x32x16_f16(ka1, qf[0], c1, 0, 0, 0);
#pragma unroll
              for (int ks = 1; ks < C::DQK / 16; ++ks) {
                  ka0 = kb0; ka1 = kb1;
                  if (ks + 1 < C::DQK / 16) { kb0 = *(const LAS h8*)(kb + 32 * (ks + 1)); kb1 = *(const LAS h8*)(kb + 32 * C::KSTR + 32 * (ks + 1)); }
                  __builtin_amdgcn_sched_barrier(0);
                  sT[0] = __builtin_amdgcn_mfma_f32_32x32x16_f16(ka0, qf[ks], sT[0], 0, 0, 0);
                  sT[1] = __builtin_amdgcn_mfma_f32_32x32x16_f16(ka1, qf[ks], sT[1], 0, 0, 0);
              }
              __builtin_amdgcn_sched_barrier(0); }
            float ps0 = 0.f, ps1 = 0.f;
            if (EXP < 9) {
            if (C::CAUSAL && t == tlim) {
                const int dq = 32 * w + qi - 64 * (t - 4 * qb) - 4 * hh;
#pragma unroll
                for (int j = 0; j < 2; ++j)
#pragma unroll
                    for (int r = 0; r < 16; ++r) { const int cr = (r & 3) + 8 * (r >> 2) + 32 * j; if (cr > dq) sT[j][r] = -INFINITY; }
            }
            float mx = max3(sT[0][0], sT[0][1], sT[1][0]);
#pragma unroll
            for (int r = 1; r < 8; ++r) mx = max3(mx, sT[0][2 * r], sT[0][2 * r + 1]);
#pragma unroll
            for (int r = 0; r < 8; ++r) mx = max3(mx, sT[1][2 * r], sT[1][2 * r + 1]);
            { const auto sw = __builtin_amdgcn_permlane32_swap(__float_as_uint(mx), __float_as_uint(mx), false, false);
              mx = fmaxf(__uint_as_float(sw[0]), __uint_as_float(sw[1])); }
            { const bool need = init ? (mx > 8.0f) : (mx > -INFINITY);
              if (__builtin_amdgcn_ballot_w64(need) != 0ull) {
                const float grow = need ? mx : 0.f;
                const float alpha = (need && init) ? __builtin_amdgcn_exp2f(-grow) : 1.0f;
                l_run *= alpha; mref += grow; init = init || need;
                const float nm = -mref;
#pragma unroll
                for (int d0 = 0; d0 < C::DV / 32; ++d0)
#pragma unroll
                    for (int r = 0; r < 16; ++r) { float x = o[d0][r]; mul_ip(x, alpha); o[d0][r] = x; }
#pragma unroll
                for (int r = 0; r < 16; ++r) { float x0 = sT[0][r], x1 = sT[1][r], x2 = negm[r]; sub_ip(x0, grow); sub_ip(x1, grow); set_ip(x2, nm); sT[0][r] = x0; sT[1][r] = x1; negm[r] = x2; }
              } }
            if (REV && t == tlim) { float mm = mref;
#pragma unroll
                for (int o = 1; o < 64; o <<= 1) mm = fminf(mm, bperm_f(lane ^ o, mm));
                if (lane == 0) xq[8 + w] = mm; }
            if (!(REV && MK_FOX_SKIP && __builtin_amdgcn_ballot_w64(mx > -40.0f) == 0ull)) {
#pragma unroll
            for (int r = 0; r < 16; ++r) { sT[0][r] = __builtin_amdgcn_exp2f(sT[0][r]); ps0 += sT[0][r]; sT[1][r] = __builtin_amdgcn_exp2f(sT[1][r]); ps1 += sT[1][r]; }
            l_run += ps0 + ps1;
            h8 pf[4];
#pragma unroll
            for (int s = 0; s < 4; ++s) { const int j = s >> 1, b8 = 8 * (s & 1);
                u32x4 pw; pw.x = pkh(sT[j][b8], sT[j][b8 + 1]); pw.y = pkh(sT[j][b8 + 2], sT[j][b8 + 3]); pw.z = pkh(sT[j][b8 + 4], sT[j][b8 + 5]); pw.w = pkh(sT[j][b8 + 6], sT[j][b8 + 7]);
                pf[s] = __builtin_bit_cast(h8, pw); }
            if (it + 1 < NT) ATT_WRITE(stg, p ^ 1);
            wrote = true;
            const LAS unsigned char* vb = lds + p * C::VB + vroff;
            s16x4 va0 = vtr(vb), va1 = vtr(vb + 8 * C::VSTR);
#pragma unroll
            for (int i = 0; i < 4 * (C::DV / 32); ++i) { constexpr int ND = C::DV / 32; const int d0 = i % ND, s = i / ND;
                const s16x8 av = {va0[0], va0[1], va0[2], va0[3], va1[0], va1[1], va1[2], va1[3]};
                if (i + 1 < 4 * (C::DV / 32)) { const int d1 = (i + 1) % ND, s1 = (i + 1) / ND; va0 = vtr(vb + (16 * s1) * C::VSTR + 64 * d1); va1 = vtr(vb + (16 * s1 + 8) * C::VSTR + 64 * d1); }
                __builtin_amdgcn_sched_barrier(0);
                o[d0] = __builtin_amdgcn_mfma_f32_32x32x16_f16(__builtin_bit_cast(h8, av), pf[s], o[d0], 0, 0, 0);
            }
            __builtin_amdgcn_sched_barrier(0);
            }
            }
        }
        if (KIND == FOX) { const float* cp = ud.cum + 64 * (tn > 0 ? tn : 0) + 4 * hh;
#pragma unroll
            for (int j = 0; j < 2; ++j)
#pragma unroll
                for (int g = 0; g < 4; ++g) cbn[j][g] = *(const f32x4*)(cp + 32 * j + 8 * g); }
        if (!wrote && it + 1 < NT) ATT_WRITE(stg, p ^ 1);
        if (EXP != 3) __syncthreads();
    }
#pragma unroll
    for (int i = 0; i < C::NL; ++i) asm volatile("" :: "v"(stg[i]));
#undef ATT_LOAD
#undef ATT_WRITE
    const float lt = l_run + bperm_f(lane ^ 32, l_run);
    const float inv = 1.0f / lt;
    constexpr int ORS = C::DV * 2 + 16;
    LAS unsigned char* ob = lds + w * (32 * ORS);
#pragma unroll
    for (int d0 = 0; d0 < C::DV / 32; ++d0)
#pragma unroll
        for (int rg = 0; rg < 4; ++rg) {
            u32x2 wv; wv.x = pkh(o[d0][4 * rg] * inv, o[d0][4 * rg + 1] * inv); wv.y = pkh(o[d0][4 * rg + 2] * inv, o[d0][4 * rg + 3] * inv);
            *(LAS u32x2*)(ob + qi * ORS + (32 * d0 + 8 * rg + 4 * hh) * 2) = wv;
        }
    half_t* og = ud.O + (rowq + 32 * w) * ud.op;
#pragma unroll
    for (int ps = 0; ps < (32 * (C::DV / 8)) / 64; ++ps) {
        const int c = lane + 64 * ps, row = c / (C::DV / 8), c8 = c % (C::DV / 8);
        const u32x4 v = *(const LAS u32x4*)(ob + row * ORS + 16 * c8);
        *(u32x4*)(og + (size_t)row * ud.op + 8 * c8) = v;
    }
}
}

#ifndef MK_REP_G4
#define MK_REP_G4 1
#endif
#ifndef MK_REP_THR
#define MK_REP_THR 1
#endif
__device__ __forceinline__ int q_pop(Frame& F, gu32* head) {
    if (F.tid == 0) F.MISC[16] = __hip_atomic_fetch_add(head, 1u, RLX_AGENT);
    __syncthreads();
    const int u = (int)F.MISC[16];
    __syncthreads();
    return u;
}


#if defined(MK_CKSUM)
constexpr size_t WS_DBG = WS_END + (1u << 20);
__device__ __forceinline__ void cksum(Frame& F, unsigned char* ws, int stage, size_t off, size_t bytes) {
    const u32x4* p = (const u32x4*)(ws + off); const size_t n = bytes / 16;
    unsigned x = 0u;
    for (size_t i = (size_t)blockIdx.x * NTHREADS + F.tid; i < n; i += (size_t)gridDim.x * NTHREADS) { const u32x4 v = p[i]; x ^= v.x ^ (v.y * 3u) ^ (v.z * 5u) ^ (v.w * 7u); }
#pragma unroll
    for (int o = 1; o < 64; o <<= 1) x ^= bperm_u(F.lane ^ o, x);
    if (F.lane == 0) atomicXor((unsigned*)(ws + WS_CTL) + 2048 + stage, x);
}
#define CK(stage, off, bytes) do { PHASE_VARS cksum(F, ws, (stage), (off), (bytes)); } while (0)
#else
#define CK(stage, off, bytes) do { } while (0)
#endif
#define Q_FIRST(head) q_pop(F, (head))
#define Q_AHEAD(head, var) unsigned var = 0u; if (F.tid == 0) var = __hip_atomic_fetch_add((head), 1u, RLX_AGENT)
#define Q_NEXT(var, u) do { if (F.tid == 0) F.MISC[16] = var; __syncthreads(); u = (int)F.MISC[16]; __syncthreads(); } while (0)
__global__ void __launch_bounds__(NTHREADS, 2) mk_fwd(Args args) {
    extern __shared__ __attribute__((aligned(16))) unsigned char lds_raw[];
    Frame F;
    F.lds = (LAS unsigned char*)lds_raw;
    F.MISC = (volatile LAS unsigned*)(F.lds + MISC_OFF);
    F.tid = threadIdx.x; F.lane = F.tid & 63; F.wave = __builtin_amdgcn_readfirstlane(F.tid >> 6);
    const int wave_s = F.wave;
    F.G = gridDim.x; { const int bx = blockIdx.x; F.vcu = (F.G % 8 == 0) ? (bx % 8) * (F.G / 8) + bx / 8 : bx; }
    F.ws = nullptr; F.ctl = nullptr;
#if defined(MK_ZERO_LDS)
    for (int i = F.tid; i < LDS_BYTES / 16; i += NTHREADS) *(LAS u32x4*)(F.lds + (size_t)i * 16) = (u32x4){0u, 0u, 0u, 0u};
    __syncthreads();
#endif
    if (F.tid < 32) F.MISC[F.tid] = 0u;
    __syncthreads();
#if defined(MK_SYS_ACQ)
    if (F.tid == 0) { __builtin_amdgcn_fence(__ATOMIC_ACQUIRE, ""); asm volatile("s_waitcnt vmcnt(0)" ::: "memory"); }
    __syncthreads();
#endif
    XcdBarrier bar = xcd_barrier_post((unsigned*)(kargs()->ws + WS_CTL) + CW_BAR, F.MISC + 8);
#define GRID_BAR() do { bar.bar = (unsigned*)(kargs()->ws + WS_CTL) + CW_BAR; { unsigned x_ = bar.x; asm volatile("" : "+s"(x_)); bar.x = x_; } xcd_barrier(bar); } while (0)
#define PHASE_VARS CArgs* ka = kargs(); unsigned char* ws = ka->ws; int bx_ = (int)blockIdx.x, G_ = (int)gridDim.x; asm volatile("" : "+s"(bx_), "+s"(G_)); const int bx = bx_, G = G_; (void)bx; (void)G; (void)ws; \
    { int ln_; asm volatile("v_mbcnt_lo_u32_b32 %0, -1, 0\n\tv_mbcnt_hi_u32_b32 %0, -1, %0" : "=v"(ln_)); int wv_ = wave_s; asm volatile("" : "+s"(wv_)); F.lane = ln_; F.wave = wv_; F.tid = wv_ * 64 + ln_; }
    (void)args;

    { PHASE_VARS F.ws = ws; p0_prologue(F, ka); F.ws = nullptr; }
    GRID_BAR();
#if defined(MK_L2TEST)
    { PHASE_VARS
      unsigned* X = (unsigned*)(ws + WS_END2 + (1u << 20)); unsigned* flagw = (unsigned*)(ws + WS_CTL) + 1024;
      const int NW = 16384;
      if (bx == 3) for (int i = F.tid; i < NW; i += NTHREADS) X[i] = 0xA0000000u + (unsigned)i;
      GRID_BAR();
      { unsigned acc = 0u; for (int i = F.tid; i < NW; i += NTHREADS) acc += X[i] - (0xA0000000u + (unsigned)i); if (acc != 0u) atomicOr(flagw, 1u); }
      GRID_BAR();
      if (bx == 5) for (int i = F.tid; i < NW; i += NTHREADS) X[i] = 0xB0000000u + (unsigned)i;
      GRID_BAR();
      { unsigned bad = 0u; for (int i = F.tid; i < NW; i += NTHREADS) {
#if MK_L2TEST == 2
            const unsigned v = __hip_atomic_load(X + i, __ATOMIC_RELAXED, __HIP_MEMORY_SCOPE_AGENT);
#else
            const unsigned v = X[i];
#endif
            bad |= (v != 0xB0000000u + (unsigned)i) ? 1u : 0u; }
        if (bad) atomicOr(flagw, 2u); }
      GRID_BAR(); }
#endif
#if defined(MK_EXP_PRO)
    { PHASE_VARS F.ws = ws; p0_prologue<MK_EXP_PRO>(F, ka); F.ws = nullptr; }
    GRID_BAR();
#endif

    CK(1, WS_XN, (size_t)M * D * 2 + (size_t)M * 64); CK(3, WS_W, 2 * WL_STRIDE + TAB_BYTES);
#pragma unroll 1
    for (int l = 0; l < 2; ++l) {
        { PHASE_VARS
          pg8::Gemm g{(const half_t*)(ws + WS_XN), wl_ptr(ws, l, WL_WI1), M, 2 * DFF, D}; pg8::StaticOrder So; So.init(M, 2 * DFF, G, bx);
          epi::prep_srow(F.lds, (const float*)(ws + WS_SS), So, F.tid);
          epi::EpiUp E{ws, F.lds};
          pg8::gemm_phase<epi::EpiUp, pg8::StaticOrder, true, true>(F.lds, g, So, E, F.tid); }
        GRID_BAR();
        { PHASE_VARS
          pg8::Gemm g{(const half_t*)(ws + WS_HID), wl_ptr(ws, l, WL_WO1), M, D, DFF}; pg8::StaticOrder So; So.init(M, D, G, bx);
          epi::EpiRes E{ws, 0.5f};
          pg8::gemm_phase<epi::EpiRes, pg8::StaticOrder, true, true>(F.lds, g, So, E, F.tid); }
        GRID_BAR();
        CK(7 + 16 * l, WS_XN, (size_t)M * D * 2);
        { PHASE_VARS
          pg8::Gemm g{(const half_t*)(ws + WS_XN), wl_ptr(ws, l, WL_WIN), M, NWIN, D}; pg8::StaticOrder So; So.init(M, NWIN, G, bx);
          epi::prep_srow(F.lds, (const float*)(ws + WS_SS), So, F.tid);
          epi::EpiWin E{ws, F.lds};
          pg8::gemm_phase<epi::EpiWin, pg8::StaticOrder, true, true>(F.lds, g, So, E, F.tid); }
        { PHASE_VARS
          pg8::Gemm g{(const half_t*)(ws + WS_MEMB), wl_ptr(ws, l, WL_XWKV), MM, D, D}; pg8::StaticOrder So; So.init(MM, D, G, (bx + G / 4) % G);
          epi::EpiScale<1> E{ws, F.lds, WS_MEMKV, WS_MEMSS, D, 1.0f / 1024.0f, 1.0f};
          pg8::gemm_phase<epi::EpiScale<1>, pg8::StaticOrder, true, true>(F.lds, g, So, E, F.tid); }
        GRID_BAR();
        CK(9 + 16 * l, WS_QF, WS_CUM - WS_QF);
        for (int rep4 = 0; rep4 < MK_REP_G4; ++rep4) {
        { PHASE_VARS
          const int gw = F.vcu * NWAVES + F.wave;
          for (int tile = gw; tile < NB * 6 * 32; tile += G * NWAVES) { const int bh = tile >> 5, tt = tile & 31, b_ = bh / 6, h_ = bh - 6 * b_;
              const half_t* kr = (const half_t*)(ws + WS_KF) + ((size_t)b_ * S + 64 * tt + F.lane) * 384 + 64 * h_;
              float ss = 0.f;
#pragma unroll
              for (int c = 0; c < 8; ++c) { const h8 v = *(const h8*)(kr + 8 * c);
#pragma unroll
                  for (int e = 0; e < 8; ++e) { const float x = (float)v[e]; ss = __builtin_fmaf(x, x, ss); } }
#pragma unroll
              for (int o = 1; o < 64; o <<= 1) ss = fmaxf(ss, bperm_f(F.lane ^ o, ss));
              if (F.lane == 0) ((float*)(ws + WS_KN))[tile] = sqrtf(ss) * 1.0001f; }
          if (gw < NB * 6) scan_seq((const float*)(ws + WS_SMALL), ka->in[I_BF] + l * 6, (float*)(ws + (l ? WS_CUM2 : WS_CUM)), gw, F.lane);
          __syncthreads(); }
        { PHASE_VARS
          pg8::Gemm g{(const half_t*)(ws + WS_MCQ), wl_ptr(ws, l, WL_WUQ), M, 768, 256}; pg8::StaticOrder So; So.init(M, 768, G, bx);
          epi::EpiUq E{ws};
          pg8::gemm_phase<epi::EpiUq, pg8::StaticOrder, true, true>(F.lds, g, So, E, F.tid); }
        { PHASE_VARS
          pg8::Gemm g{(const half_t*)(ws + WS_MCKV), wl_ptr(ws, l, WL_WUKV), M, 768, 128}; pg8::StaticOrder So; So.init(M, 768, G, (bx + G / 2) % G);
          epi::EpiScale<4> E{ws, F.lds, WS_KVUP, WS_SSKV, 768, 1.0f / 128.0f, 1.0f};
          pg8::gemm_phase<epi::EpiScale<4>, pg8::StaticOrder, true, true>(F.lds, g, So, E, F.tid); }
        }
        for (int rep4 = 0; rep4 < MK_REP_THR; ++rep4) {
        { PHASE_VARS
          gu32* head = (gu32*)(ws + WS_CTL) + CW_QUEUE + 64 * (l * 4 + 0 + 16 * rep4);
          for (int u = Q_FIRST(head); u < NB * 128;) { Q_AHEAD(head, nxt_);
              const int qt = 127 - (u >> 4), b = u & 15;
#if defined(MK_EXP_THR)
              if (rep4 == 1) dsa::thr_unit<MK_EXP_THR>(F, b, qt, (const half_t*)(ws + WS_DQI), (const half_t*)(ws + WS_DKI), (const float*)(ws + WS_SMALL), (unsigned*)(ws + WS_END) - (size_t)b * S * 64 - (size_t)16 * qt * 64); else
#endif
              dsa::thr_unit(F, b, qt, (const half_t*)(ws + WS_DQI), (const half_t*)(ws + WS_DKI), (const float*)(ws + WS_SMALL), (unsigned*)(ws + WS_MASK));
              Q_NEXT(nxt_, u); } }
        }
        GRID_BAR();
        CK(10 + 16 * l, WS_CUM, WS_MASK - WS_CUM); CK(11 + 16 * l, WS_MASK, (size_t)M * 256);
        { PHASE_VARS
          gu32* head = (gu32*)(ws + WS_CTL) + CW_QUEUE + 64 * (l * 4 + 1);
          half_t* MIX = (half_t*)(ws + WS_MIX);
          for (int u = Q_FIRST(head); u < 2048;) { Q_AHEAD(head, nxt_);
              const int qb = u < 1280 ? 7 - u / 160 : 7 - (u - 1280) / 96, j = u < 1280 ? (u % 160 < 96 ? u % 160 : u % 160 + 96) : 96 + (u - 1280) % 96;
              att::UD ud{}; ud.base = ws;
              if (j < 96) { const int b = j / 6, h = j - 6 * b; const half_t* kv = (const half_t*)(ws + WS_KVUP) + 128 * h;
                  ud.Q = (const half_t*)(ws + WS_QUP) + 96 * h; ud.qp = 576; ud.K0 = kv; ud.kp0 = 768; ud.K1 = (const half_t*)(ws + WS_KR); ud.kp1 = 32; ud.V = kv + 64; ud.vp = 768;
                  ud.O = MIX + 384 + 64 * h; ud.op = D; ud.cum = nullptr; ud.mask = nullptr;
                  att::attn_unit<att::MLA>(F, ud, (size_t)b * S, (size_t)b * S + 256 * qb, qb);
              } else if (j < 192) { const int jj = j - 96, b = jj / 6, h = jj - 6 * b;
                  ud.Q = (const half_t*)(ws + WS_QF) + 64 * h; ud.qp = 384; ud.K0 = (const half_t*)(ws + WS_KF) + 64 * h; ud.kp0 = 384; ud.K1 = ud.K0; ud.kp1 = 384; ud.V = (const half_t*)(ws + WS_VF) + 64 * h; ud.vp = 384;
                  ud.O = MIX + 64 * h; ud.op = D; ud.cum = (const float*)(ws + (l ? WS_CUM2 : WS_CUM)) + (size_t)(b * 6 + h) * S; ud.mask = nullptr; ud.kn = (const float*)(ws + WS_KN) + (size_t)(b * 6 + h) * 32;
                  att::attn_unit<att::FOX>(F, ud, (size_t)b * S, (size_t)b * S + 256 * qb, qb);
              } else { const int jj = j - 192, b = jj >> 2, h = jj & 3;
                  ud.Q = (const half_t*)(ws + WS_DQ) + 64 * h; ud.qp = 256; ud.K0 = (const half_t*)(ws + WS_DK); ud.kp0 = 64; ud.K1 = ud.K0; ud.kp1 = 64; ud.V = (const half_t*)(ws + WS_DV); ud.vp = 64;
                  ud.O = MIX + 768 + 64 * h; ud.op = D; ud.cum = nullptr; ud.mask = (const unsigned*)(ws + WS_MASK) + (size_t)b * S * 64;
                  att::attn_unit<att::DSA>(F, ud, (size_t)b * S, (size_t)b * S + 256 * qb, qb);
              }
              Q_NEXT(nxt_, u); } }
        GRID_BAR();
        CK(13 + 16 * l, WS_MIX, (size_t)M * D * 2);
        { PHASE_VARS
          pg8::Gemm g{(const half_t*)(ws + WS_MIX), wl_ptr(ws, l, WL_WOUT), M, D, D}; pg8::StaticOrder So; So.init(M, D, G, bx);
          epi::EpiRes E{ws, 1.0f};
          pg8::gemm_phase<epi::EpiRes, pg8::StaticOrder, true, true>(F.lds, g, So, E, F.tid); }
        GRID_BAR();
        { PHASE_VARS
          pg8::Gemm g{(const half_t*)(ws + WS_XN), wl_ptr(ws, l, WL_XWQ), M, 512, D}; pg8::StaticOrder So; So.init(M, 512, G, bx);
          epi::prep_srow(F.lds, (const float*)(ws + WS_SS), So, F.tid);
          epi::EpiScale<16> E{ws, F.lds, WS_QX, WS_SS, 512, 1.0f / 1024.0f, 0.08838834764831845f * LOG2E};
          pg8::gemm_phase<epi::EpiScale<16>, pg8::StaticOrder, true, true>(F.lds, g, So, E, F.tid); }
        GRID_BAR();
        { PHASE_VARS
          for (int u = bx; u < NB * 4 * 8; u += G) {
            const int qb = u & 7, bh = u >> 3, b = bh >> 2, h = bh & 3;
            att::UD ud{}; ud.base = ws; const half_t* kv = (const half_t*)(ws + WS_MEMKV) + 128 * h;
            ud.Q = (const half_t*)(ws + WS_QX) + 128 * h; ud.qp = 512; ud.K0 = kv; ud.kp0 = D; ud.K1 = kv; ud.kp1 = D; ud.V = kv + 512; ud.vp = D;
            ud.O = (half_t*)(ws + WS_OX) + 128 * h; ud.op = 512; ud.cum = nullptr; ud.mask = nullptr;
            att::attn_unit<att::XA>(F, ud, (size_t)b * MEM, (size_t)b * S + 256 * qb, qb);
            __syncthreads();
          } }
        GRID_BAR();
        { PHASE_VARS
          pg8::Gemm g{(const half_t*)(ws + WS_OX), wl_ptr(ws, l, WL_XWO), M, D, 512}; pg8::StaticOrder So; So.init(M, D, G, bx);
          epi::EpiRes E{ws, 1.0f};
          pg8::gemm_phase<epi::EpiRes, pg8::StaticOrder, true, true>(F.lds, g, So, E, F.tid); }
        GRID_BAR();
        CK(17 + 16 * l, WS_XN, (size_t)M * D * 2);
        { PHASE_VARS
          pg8::Gemm g{(const half_t*)(ws + WS_XN), wl_ptr(ws, l, WL_WI2), M, 2 * DFF, D}; pg8::StaticOrder So; So.init(M, 2 * DFF, G, bx);
          epi::prep_srow(F.lds, (const float*)(ws + WS_SS), So, F.tid);
          epi::EpiUp E{ws, F.lds};
          pg8::gemm_phase<epi::EpiUp, pg8::StaticOrder, true, true>(F.lds, g, So, E, F.tid); }
        GRID_BAR();
        { PHASE_VARS
          pg8::Gemm g{(const half_t*)(ws + WS_HID), wl_ptr(ws, l, WL_WO2), M, D, DFF}; pg8::StaticOrder So; So.init(M, D, G, bx);
          epi::EpiRes E{ws, 0.5f};
          pg8::gemm_phase<epi::EpiRes, pg8::StaticOrder, true, true>(F.lds, g, So, E, F.tid); }
        GRID_BAR();
    }
#if defined(MK_CKSUM)
    CK(40, WS_XN, (size_t)M * D * 2);
    GRID_BAR();
    { PHASE_VARS
      unsigned* cur = (unsigned*)(ws + WS_CTL) + 2048; unsigned* pst = (unsigned*)(ws + WS_DBG);
      if (blockIdx.x == 0 && F.tid == 0) {
          const bool have = pst[0] == 0x5eedc0deu && pst[1] == 0x0badf00du;
          unsigned first = 0u;
          if (have) for (int s = 1; s <= 40; ++s) if (first == 0u && __hip_atomic_load(cur + s, RLX_AGENT) != pst[64 + s]) first = (unsigned)s;
          for (int s = 1; s <= 40; ++s) pst[64 + s] = __hip_atomic_load(cur + s, RLX_AGENT);
          if (!have) { pst[0] = 0x5eedc0deu; pst[1] = 0x0badf00du; pst[2] = 0u; }
          else if (pst[2] == 0u && first != 0u) pst[2] = first;
      } }
#endif
    { PHASE_VARS
      const float* gn = ka->in[I_FINN]; float* out = ka->out; const float* SS = (const float*)(ws + WS_SS); const half_t* XN = (const half_t*)(ws + WS_XN);
      const int gw = F.vcu * NWAVES + F.wave, NGW = G * NWAVES;
      f32x4 gv[4];
#pragma unroll
      for (int j = 0; j < 4; ++j) gv[j] = *((const GAS f32x4*)gn + F.lane + 64 * j);
      for (int m0 = gw; m0 < M; m0 += 4 * NGW) {
          u32x2 xv[4][4]; float sc[4];
#pragma unroll
          for (int u = 0; u < 4; ++u) { const int m = m0 + u * NGW; if (m < M) { const GAS u32x2* xr = (const GAS u32x2*)(XN + (size_t)m * D) + F.lane;
#pragma unroll
              for (int j = 0; j < 4; ++j) xv[u][j] = xr[64 * j];
              sc[u] = epi::rs_from(epi::row_ss<16>(SS, m), 1.0f / 1024.0f); } }
#pragma unroll
          for (int u = 0; u < 4; ++u) { const int m = m0 + u * NGW; if (m < M) { GAS f32x4* orow = (GAS f32x4*)(out + (size_t)m * D) + F.lane; const float s = sc[u];
#pragma unroll
              for (int j = 0; j < 4; ++j) { const h4 v = __builtin_bit_cast(h4, xv[u][j]);
                  f32x4 o = {(float)v[0] * s * gv[j][0], (float)v[1] * s * gv[j][1], (float)v[2] * s * gv[j][2], (float)v[3] * s * gv[j][3]}; orow[64 * j] = o; } } }
      } }
}

extern "C" void kernel_launch(void* const* d_in, const int* in_sizes, int n_in, void* d_out, int out_size, void* d_ws, size_t ws_size, hipStream_t stream) {
    static int grid = 0;
    if (grid == 0) {
        if (n_in != 22 || in_sizes[0] != M * D || out_size != M * D || ws_size < WS_END2) {
            fprintf(stderr, "kernel_launch: unexpected shapes: n_in %d in0 %d out %d ws %zu (need %zu)\n", n_in, n_in > 0 ? in_sizes[0] : -1, out_size, ws_size, (size_t)WS_END); grid = -1; return; }
        int dev = 0, cus = 0, per_cu = 0;
        if (hipGetDevice(&dev) != hipSuccess || hipDeviceGetAttribute(&cus, hipDeviceAttributeMultiprocessorCount, dev) != hipSuccess) { grid = -1; return; }
        if (hipFuncSetAttribute((const void*)mk_fwd, hipFuncAttributeMaxDynamicSharedMemorySize, LDS_BYTES) != hipSuccess) { fprintf(stderr, "kernel_launch: hipFuncSetAttribute failed\n"); grid = -1; return; }
        if (hipOccupancyMaxActiveBlocksPerMultiprocessor(&per_cu, (const void*)mk_fwd, NTHREADS, LDS_BYTES) != hipSuccess || per_cu < 1)
            fprintf(stderr, "kernel_launch: occupancy query reports %d workgroups per CU\n", per_cu);
        (void)hipGetLastError();
        grid = cus;
    }
    if (grid < 0) return;
    if (hipMemsetAsync((char*)d_ws + WS_CTL, 0, CTL_ZERO_BYTES, stream) != hipSuccess) return;
    Args a{};
    for (int i = 0; i < 22; ++i) a.in[i] = (const float*)d_in[i];
    a.out = (float*)d_out; a.ws = (unsigned char*)d_ws;
    hipLaunchKernelGGL(mk_fwd, dim3(grid), dim3(NTHREADS), LDS_BYTES, stream, a);
}
```
